# Optimizing an MI355X kernel written in HIP

```python
import math
import jax
import jax.numpy as jnp
from jax import lax
import numpy as np

D_MODEL = 1024
BATCH = 4
SEQ = 8192
DEPTH = 4

CTX_LEN = 256
GRID_W = 64
N_MOD = 6
EPS = 1e-6

FNET_GROUPS = 4
FNET_GROUP_DIM = 64
FNET_WIDTH = FNET_GROUPS * FNET_GROUP_DIM
S5_GROUP_CH = 16
S5_WIDTH = D_MODEL - FNET_WIDTH
S5_GROUPS = S5_WIDTH // S5_GROUP_CH
S5_STATE = 64
S5_STEP_MIN = 1e-3
S5_STEP_MAX = 1e-1
EVEN_IN = FNET_WIDTH + S5_WIDTH

SGU_GROUPS = 4
SGU_GROUP_DIM = 128
SGU_WIDTH = SGU_GROUPS * SGU_GROUP_DIM
SGU_CHUNK = 128
DIFF_HEADS = 4
DIFF_HEAD_DIM = 64
DIFF_V_DIM = 2 * DIFF_HEAD_DIM
DIFF_QK_WIDTH = DIFF_HEADS * 2 * DIFF_HEAD_DIM
DIFF_WIDTH = DIFF_HEADS * DIFF_V_DIM
ROPE_AXIS_DIM = DIFF_HEAD_DIM // 2
ROPE_BASE = 10000.0
Q_BLOCK = 128
Q_OFF = 2 * SGU_WIDTH
KV_OFF = Q_OFF + DIFF_QK_WIDTH
ODD_IN = KV_OFF + DIFF_QK_WIDTH + DIFF_WIDTH
ODD_OUT = SGU_WIDTH + DIFF_WIDTH

N_EXPERTS = 32
TOP_K = 4
D_EXPERT = D_MODEL
SWIGLU_ALPHA = 1.702
SWIGLU_LIMIT = 7.0
MOE_BLOCK = 256

N_EVEN = (DEPTH + 1) // 2
N_ODD = DEPTH // 2

kernel_name = 'hybrid_fnet_s5_gmlp_diffattn_moe_dit'


def rms_norm(x, g):
    xf = x.astype(jnp.float32)
    y = xf * lax.rsqrt(jnp.mean(xf * xf, axis=-1, keepdims=True) + EPS) * g.astype(jnp.float32)
    return y.astype(x.dtype)


def modulate(h, shift, scale):
    return h * (1.0 + scale) + shift


def fourier_mix(a):
    b_, l_, _ = a.shape
    ag = a.reshape(b_, l_, FNET_GROUPS, FNET_GROUP_DIM).astype(jnp.float32)
    f = jnp.fft.fftn(ag, axes=(1, 3), norm='ortho')
    return f.real.reshape(b_, l_, FNET_WIDTH).astype(a.dtype)


def _linear_combine(e1, e2):
    a1, b1 = e1
    a2, b2 = e2
    return a1 * a2, a2 * b1 + b2


def diag_scan(bu, a_bar, h0, reverse):
    l_ = bu.shape[1]
    if h0 is not None:
        first = l_ - 1 if reverse else 0
        bu = bu.at[:, first].add(a_bar * h0)
    a = jnp.broadcast_to(a_bar, (1, l_) + a_bar.shape)
    _, h = lax.associative_scan(_linear_combine, (a, bu), reverse=reverse, axis=1)
    return h


def s5_mix(u_ctx, u_lat, lam_re, lam_im, log_step, b_re, b_im, c_re, c_im, d_skip, glu_w, glu_b, ctx_out):
    f32 = jnp.float32
    lam = lax.complex(lam_re.astype(f32), lam_im.astype(f32))
    step = jnp.exp(log_step.astype(f32))[..., None]
    a_bar = jnp.exp(lam * step)
    b_bar = ((a_bar - 1.0) / lam)[..., None] * lax.complex(b_re.astype(f32), b_im.astype(f32))
    c_mat = lax.complex(c_re.astype(f32), c_im.astype(f32))
    d = d_skip.astype(f32)

    def groups(u):
        return u.reshape(u.shape[0], u.shape[1], S5_GROUPS, S5_GROUP_CH).astype(f32)

    def drive(ug, dr):
        return jnp.einsum('blgc,gnc->blgn', ug.astype(jnp.complex64), b_bar[dr])

    def readout(h, dr):
        return jnp.einsum('blgn,gcn->blgc', h, c_mat[dr]).real

    def glu_out(y, like):
        y = jax.nn.gelu(y).reshape(like.shape).astype(like.dtype)
        return y * jax.nn.sigmoid(y @ glu_w + glu_b)

    gc = groups(u_ctx)
    gl = groups(u_lat)
    hf_c = diag_scan(drive(gc, 0), a_bar[0], None, False)
    hb_c = diag_scan(drive(gc, 1), a_bar[1], None, True)
    hf_l = diag_scan(drive(gl, 0), a_bar[0], hf_c[:, -1], False)
    hb_l = diag_scan(drive(gl, 1), a_bar[1], hb_c[:, 0], True)
    y_lat = glu_out(readout(hf_l, 0) + readout(hb_l, 1) + d * gl, u_lat)
    y_ctx = glu_out(readout(hf_c, 0) + readout(hb_c, 1) + d * gc, u_ctx) if ctx_out else None
    return y_ctx, y_lat


def even_mixer(n_ctx, n_lat, w_in, w_out, lam_re, lam_im, log_step, b_re, b_im, c_re, c_im, d_skip,
               glu_w, glu_b, ctx_out):
    z_lat = n_lat @ w_in
    if ctx_out:
        z_ctx = n_ctx @ w_in
        u_ctx = z_ctx[..., FNET_WIDTH:]
    else:
        u_ctx = n_ctx @ w_in[:, FNET_WIDTH:]
    y_ctx_s5, y_lat_s5 = s5_mix(u_ctx, z_lat[..., FNET_WIDTH:], lam_re, lam_im, log_step, b_re, b_im,
                                c_re, c_im, d_skip, glu_w, glu_b, ctx_out)
    out_lat = jnp.concatenate([fourier_mix(z_lat[..., :FNET_WIDTH]), y_lat_s5], axis=-1) @ w_out
    out_ctx = None
    if ctx_out:
        out_ctx = jnp.concatenate([fourier_mix(z_ctx[..., :FNET_WIDTH]), y_ctx_s5], axis=-1) @ w_out
    return out_ctx, out_lat


def spatial_gating(u, v, ln_g, ln_b, w_s, b_s):
    b_, l_, _ = u.shape
    nc = l_ // SGU_CHUNK
    vg = v.reshape(b_, nc, SGU_CHUNK, SGU_GROUPS, SGU_GROUP_DIM).astype(jnp.float32)
    mu = jnp.mean(vg, axis=-1, keepdims=True)
    var = jnp.mean(jnp.square(vg - mu), axis=-1, keepdims=True)
    vn = (vg - mu) * lax.rsqrt(var + EPS) * ln_g.astype(jnp.float32) + ln_b.astype(jnp.float32)
    vm = jnp.einsum('bnpgc,gqp->bnqgc', vn, w_s.astype(jnp.float32)) + b_s.astype(jnp.float32).T[:, :, None]
    ug = u.reshape(b_, nc, SGU_CHUNK, SGU_GROUPS, SGU_GROUP_DIM)
    return (ug * vm).reshape(b_, l_, SGU_WIDTH).astype(u.dtype)


def axial_rope_tables(l_):
    rows = l_ // GRID_W
    r, col = jnp.meshgrid(jnp.arange(rows), jnp.arange(GRID_W), indexing='ij')
    inv_freq = jnp.power(ROPE_BASE, -jnp.arange(0, ROPE_AXIS_DIM, 2, dtype=jnp.float32) / ROPE_AXIS_DIM)
    ang_r = r.reshape(-1).astype(jnp.float32)[:, None] * inv_freq
    ang_c = col.reshape(-1).astype(jnp.float32)[:, None] * inv_freq
    ex = lambda a: a[:, None, None, :]
    return ex(jnp.cos(ang_r)), ex(jnp.sin(ang_r)), ex(jnp.cos(ang_c)), ex(jnp.sin(ang_c))


def _rotate(x, cos, sin):
    x1, x2 = jnp.split(x, 2, axis=-1)
    return jnp.concatenate([x1 * cos - x2 * sin, x2 * cos + x1 * sin], axis=-1)


def axial_rope(x, rope):
    cr, sr, cc, sc = rope
    xf = x.astype(jnp.float32)
    y = jnp.concatenate([_rotate(xf[..., :ROPE_AXIS_DIM], cr, sr),
                         _rotate(xf[..., ROPE_AXIS_DIM:], cc, sc)], axis=-1)
    return y.astype(x.dtype)


def diff_attention(q, k, v, lam):
    b_, lq = q.shape[:2]
    nb = lq // Q_BLOCK
    qb = q.reshape(b_, nb, Q_BLOCK, DIFF_HEADS, 2, DIFF_HEAD_DIM).transpose(1, 0, 2, 3, 4, 5)
    scale = DIFF_HEAD_DIM ** -0.5

    def one(qblk):
        s = jnp.einsum('bqhjd,bkhjd->bhjqk', qblk, k, preferred_element_type=jnp.float32) * scale
        p = jax.nn.softmax(s, axis=-1)
        w = (p[:, :, 0] - lam * p[:, :, 1]).astype(v.dtype)
        return jnp.einsum('bhqk,bkhe->bqhe', w, v)

    o = lax.map(one, qb)
    return o.transpose(1, 0, 2, 3, 4).reshape(b_, lq, DIFF_HEADS, DIFF_V_DIM)


def _heads_qk(t):
    return t.reshape(t.shape[0], t.shape[1], DIFF_HEADS, 2, DIFF_HEAD_DIM)


def _heads_v(t):
    return t.reshape(t.shape[0], t.shape[1], DIFF_HEADS, DIFF_V_DIM)


def odd_mixer(n_ctx, n_lat, w_in, w_out, ln_g, ln_b, w_s, b_s, lq1, lk1, lq2, lk2, subln_g, rope,
              lam_init, ctx_out):
    f32 = jnp.float32
    z_lat = n_lat @ w_in
    if ctx_out:
        z_ctx = n_ctx @ w_in
        kv_ctx = z_ctx[..., KV_OFF:]
    else:
        kv_ctx = n_ctx @ w_in[:, KV_OFF:]
    k_ctx = _heads_qk(kv_ctx[..., :DIFF_QK_WIDTH])
    v_ctx = _heads_v(kv_ctx[..., DIFF_QK_WIDTH:])
    lam = (jnp.exp(jnp.sum(lq1.astype(f32) * lk1.astype(f32)))
           - jnp.exp(jnp.sum(lq2.astype(f32) * lk2.astype(f32))) + lam_init)

    def attn_out(q, k, v):
        o = rms_norm(diff_attention(q, k, v, lam), subln_g) * (1.0 - lam_init)
        return o.reshape(q.shape[0], q.shape[1], DIFF_WIDTH)

    def sgu_out(z):
        return spatial_gating(jax.nn.gelu(z[..., :SGU_WIDTH]), jax.nn.gelu(z[..., SGU_WIDTH:Q_OFF]),
                              ln_g, ln_b, w_s, b_s)

    q_lat = axial_rope(_heads_qk(z_lat[..., Q_OFF:KV_OFF]), rope)
    k_lat = axial_rope(_heads_qk(z_lat[..., KV_OFF:KV_OFF + DIFF_QK_WIDTH]), rope)
    v_lat = _heads_v(z_lat[..., KV_OFF + DIFF_QK_WIDTH:])
    k_all = jnp.concatenate([k_ctx, k_lat], axis=1)
    v_all = jnp.concatenate([v_ctx, v_lat], axis=1)
    out_lat = jnp.concatenate([sgu_out(z_lat), attn_out(q_lat, k_all, v_all)], axis=-1) @ w_out
    out_ctx = None
    if ctx_out:
        q_ctx = _heads_qk(z_ctx[..., Q_OFF:KV_OFF])
        out_ctx = jnp.concatenate([sgu_out(z_ctx), attn_out(q_ctx, k_ctx, v_ctx)], axis=-1) @ w_out
    return out_ctx, out_lat


def moe_ffn(h, router_w, router_b, w1, b1, w2, b2):
    n_tok, d_ = h.shape
    logits = (h @ router_w).astype(jnp.float32) + router_b.astype(jnp.float32)
    top_val, top_idx = lax.top_k(logits, TOP_K)
    gates = jax.nn.softmax(top_val, axis=-1).astype(h.dtype)
    n_assign = n_tok * TOP_K
    flat_e = top_idx.reshape(-1)
    order = jnp.argsort(flat_e)
    e_sorted = flat_e[order]
    tok_sorted = order // TOP_K
    gate_sorted = gates.reshape(-1)[order]
    counts = jnp.bincount(flat_e, length=N_EXPERTS)
    starts = jnp.cumsum(counts) - counts
    padded = (counts + MOE_BLOCK - 1) // MOE_BLOCK * MOE_BLOCK
    pad_ends = jnp.cumsum(padded)
    pad_starts = pad_ends - padded
    dest = pad_starts[e_sorted] + jnp.arange(n_assign) - starts[e_sorted]
    n_rows = (-(-n_assign // MOE_BLOCK) + N_EXPERTS) * MOE_BLOCK
    n_blocks = n_rows // MOE_BLOCK
    block_e = jnp.minimum(jnp.searchsorted(pad_ends, jnp.arange(n_blocks) * MOE_BLOCK, side='right'),
                          N_EXPERTS - 1)
    x_rows = jnp.zeros((n_rows, d_), h.dtype).at[dest].set(h[tok_sorted])

    def expert_block(args):
        xb, e = args
        hh = xb @ w1[e] + b1[e]
        glu = jnp.minimum(hh[:, :D_EXPERT], SWIGLU_LIMIT)
        lin = jnp.clip(hh[:, D_EXPERT:], -SWIGLU_LIMIT, SWIGLU_LIMIT)
        act = glu * jax.nn.sigmoid(SWIGLU_ALPHA * glu) * (lin + 1.0)
        return act @ w2[e] + b2[e]

    y_rows = lax.map(expert_block, (x_rows.reshape(n_blocks, MOE_BLOCK, d_), block_e)).reshape(n_rows, d_)
    y = y_rows[dest] * gate_sorted[:, None]
    return jax.ops.segment_sum(y, tok_sorted, num_segments=n_tok)


def setup_inputs(seed: int = 0) -> dict:
    key = jax.random.key(seed)
    ks = iter(jax.random.split(key, 48))
    f32 = jnp.float32

    def nrm(shape, scale):
        return scale * jax.random.normal(next(ks), shape, f32)

    n_idx = jnp.arange(S5_STATE, dtype=f32)
    s5_shape = (N_EVEN, 2, S5_GROUPS, S5_STATE)
    return {
        'x': nrm((BATCH, SEQ, D_MODEL), 1.0),
        'c': nrm((BATCH, D_MODEL), 1.0),
        'ctx': nrm((BATCH, CTX_LEN, D_MODEL), 1.0),
        'c_ctx': nrm((D_MODEL,), 1.0),
        'ada_w': nrm((DEPTH, D_MODEL, N_MOD * D_MODEL), 0.5 * D_MODEL ** -0.5),
        'ada_b': nrm((DEPTH, N_MOD * D_MODEL), 0.01),
        'norm1_g': 1.0 + nrm((DEPTH, D_MODEL), 0.02),
        'norm2_g': 1.0 + nrm((DEPTH, D_MODEL), 0.02),
        'ev_w_in': nrm((N_EVEN, D_MODEL, EVEN_IN), D_MODEL ** -0.5),
        'ev_w_out': nrm((N_EVEN, EVEN_IN, D_MODEL), EVEN_IN ** -0.5),
        's5_lam_re': -0.5 + nrm(s5_shape, 0.01),
        's5_lam_im': math.pi * n_idx + nrm(s5_shape, 0.01),
        's5_log_step': jax.random.uniform(next(ks), (N_EVEN, 2, S5_GROUPS), f32,
                                          math.log(S5_STEP_MIN), math.log(S5_STEP_MAX)),
        's5_b_re': nrm((N_EVEN, 2, S5_GROUPS, S5_STATE, S5_GROUP_CH), (2 * S5_GROUP_CH) ** -0.5),
        's5_b_im': nrm((N_EVEN, 2, S5_GROUPS, S5_STATE, S5_GROUP_CH), (2 * S5_GROUP_CH) ** -0.5),
        's5_c_re': nrm((N_EVEN, 2, S5_GROUPS, S5_GROUP_CH, S5_STATE), (2 * S5_STATE) ** -0.5),
        's5_c_im': nrm((N_EVEN, 2, S5_GROUPS, S5_GROUP_CH, S5_STATE), (2 * S5_STATE) ** -0.5),
        's5_d': nrm((N_EVEN, S5_GROUPS, S5_GROUP_CH), 1.0),
        's5_glu_w': nrm((N_EVEN, S5_WIDTH, S5_WIDTH), S5_WIDTH ** -0.5),
        's5_glu_b': nrm((N_EVEN, S5_WIDTH), 0.01),
        'od_w_in': nrm((N_ODD, D_MODEL, ODD_IN), D_MODEL ** -0.5),
        'od_w_out': nrm((N_ODD, ODD_OUT, D_MODEL), ODD_OUT ** -0.5),
        'sgu_ln_g': 1.0 + nrm((N_ODD, SGU_GROUPS, SGU_GROUP_DIM), 0.02),
        'sgu_ln_b': nrm((N_ODD, SGU_GROUPS, SGU_GROUP_DIM), 0.02),
        'sgu_w': nrm((N_ODD, SGU_GROUPS, SGU_CHUNK, SGU_CHUNK), SGU_CHUNK ** -0.5),
        'sgu_b': 1.0 + nrm((N_ODD, SGU_GROUPS, SGU_CHUNK), 0.1),
        'diff_lq1': nrm((N_ODD, DIFF_HEAD_DIM), 0.1),
        'diff_lk1': nrm((N_ODD, DIFF_HEAD_DIM), 0.1),
        'diff_lq2': nrm((N_ODD, DIFF_HEAD_DIM), 0.1),
        'diff_lk2': nrm((N_ODD, DIFF_HEAD_DIM), 0.1),
        'diff_subln_g': 1.0 + nrm((N_ODD, DIFF_V_DIM), 0.02),
        'router_w': nrm((DEPTH, D_MODEL, N_EXPERTS), D_MODEL ** -0.5),
        'router_b': nrm((DEPTH, N_EXPERTS), 0.01),
        'exp_w1': nrm((DEPTH, N_EXPERTS, D_MODEL, 2 * D_EXPERT), D_MODEL ** -0.5),
        'exp_b1': nrm((DEPTH, N_EXPERTS, 2 * D_EXPERT), 0.01),
        'exp_w2': nrm((DEPTH, N_EXPERTS, D_EXPERT, D_MODEL), D_EXPERT ** -0.5),
        'exp_b2': nrm((DEPTH, N_EXPERTS, D_MODEL), 0.01),
        'final_g': 1.0 + nrm((D_MODEL,), 0.02),
    }


def reference(x, c, ctx, c_ctx, ada_w, ada_b, norm1_g, norm2_g, ev_w_in, ev_w_out, s5_lam_re, s5_lam_im,
              s5_log_step, s5_b_re, s5_b_im, s5_c_re, s5_c_im, s5_d, s5_glu_w, s5_glu_b, od_w_in, od_w_out,
              sgu_ln_g, sgu_ln_b, sgu_w, sgu_b, diff_lq1, diff_lk1, diff_lq2, diff_lk2, diff_subln_g,
              router_w, router_b, exp_w1, exp_b1, exp_w2, exp_b2, final_g):
    b_, l_, d_ = x.shape
    rope = axial_rope_tables(l_)
    c_act = jax.nn.silu(c)
    cc_act = jax.nn.silu(c_ctx)
    h_lat, h_ctx = x, ctx
    for i in range(DEPTH):
        ctx_out = i < DEPTH - 1
        sh1, sc1, g1, sh2, sc2, g2 = jnp.split((c_act @ ada_w[i] + ada_b[i])[:, None, :], N_MOD, axis=-1)
        csh1, csc1, cg1, csh2, csc2, cg2 = jnp.split(cc_act @ ada_w[i] + ada_b[i], N_MOD, axis=-1)
        n_lat = modulate(rms_norm(h_lat, norm1_g[i]), sh1, sc1)
        n_ctx = modulate(rms_norm(h_ctx, norm1_g[i]), csh1, csc1)
        j = i // 2
        if i % 2 == 0:
            y_ctx, y_lat = even_mixer(n_ctx, n_lat, ev_w_in[j], ev_w_out[j], s5_lam_re[j], s5_lam_im[j],
                                      s5_log_step[j], s5_b_re[j], s5_b_im[j], s5_c_re[j], s5_c_im[j],
                                      s5_d[j], s5_glu_w[j], s5_glu_b[j], ctx_out)
        else:
            lam_init = 0.8 - 0.6 * math.exp(-0.3 * i)
            y_ctx, y_lat = odd_mixer(n_ctx, n_lat, od_w_in[j], od_w_out[j], sgu_ln_g[j], sgu_ln_b[j], sgu_w[j],
                                     sgu_b[j], diff_lq1[j], diff_lk1[j], diff_lq2[j], diff_lk2[j],
                                     diff_subln_g[j], rope, lam_init, ctx_out)
        h_lat = h_lat + g1 * y_lat
        m_lat = modulate(rms_norm(h_lat, norm2_g[i]), sh2, sc2)
        f_lat = moe_ffn(m_lat.reshape(b_ * l_, d_), router_w[i], router_b[i], exp_w1[i], exp_b1[i],
                        exp_w2[i], exp_b2[i])
        h_lat = h_lat + g2 * f_lat.reshape(b_, l_, d_)
        if ctx_out:
            h_ctx = h_ctx + cg1 * y_ctx
            m_ctx = modulate(rms_norm(h_ctx, norm2_g[i]), csh2, csc2)
            f_ctx = moe_ffn(m_ctx.reshape(-1, d_), router_w[i], router_b[i], exp_w1[i], exp_b1[i],
                            exp_w2[i], exp_b2[i])
            h_ctx = h_ctx + cg2 * f_ctx.reshape(h_ctx.shape)
    return rms_norm(h_lat, final_g)
```

```cpp
#include <hip/hip_runtime.h>
#include <stdio.h>

#define GAS __attribute__((address_space(1)))
#define LAS __attribute__((address_space(3)))
typedef unsigned short bf16;
typedef unsigned v4u __attribute__((ext_vector_type(4)));
typedef unsigned v2u __attribute__((ext_vector_type(2)));
typedef float f32x4 __attribute__((ext_vector_type(4)));
typedef float f32x2 __attribute__((ext_vector_type(2)));
typedef float f32x16 __attribute__((ext_vector_type(16)));
typedef short bf16x8 __attribute__((ext_vector_type(8)));
typedef short s16x4 __attribute__((ext_vector_type(4)));
typedef int v8i __attribute__((ext_vector_type(8)));
typedef int v4i __attribute__((ext_vector_type(4)));
typedef GAS unsigned gu32;
#define RLX_AGENT __ATOMIC_RELAXED, __HIP_MEMORY_SCOPE_AGENT
#define DI __device__ __forceinline__

constexpr int NLAT = 32768, NCTX = 1024, NTOK = NLAT + NCTX, DM = 1024, SEQ = 8192, CTXL = 256, NB = 4;
constexpr int NEXP = 32, TOPK = 4;
constexpr float EPS = 1e-6f;
constexpr int S5T = 32;
constexpr int S5ROWS = 1280;
constexpr int S5K = 768;
constexpr int XR_ROWS = 143360;
constexpr int KV_LEN = 8448;

constexpr size_t MiB = 1u << 20;
constexpr size_t WS_CTL = 0, CTL_ZERO_BYTES = 2 * MiB;
constexpr size_t WS_MOD = 2 * MiB;
constexpr size_t WS_AM = 2 * MiB + 524288;
constexpr size_t WS_CB = 2 * MiB + 524288 + 131072;
constexpr size_t WS_ROPE = 3 * MiB;
constexpr size_t WS_TW = 3 * MiB + 65536;
constexpr size_t WS_APT = 3 * MiB + 131072;
constexpr size_t WS_H = 4 * MiB;
constexpr size_t WS_XN = 136 * MiB;
constexpr size_t WS_CAT = 202 * MiB;
constexpr size_t WS_WEV_S5 = 268 * MiB;
constexpr size_t WS_WEV_PQ = 271 * MiB;
constexpr size_t WS_WEV_OUT = 273 * MiB;
constexpr size_t WS_GLUW = 277 * MiB;
constexpr size_t WS_WOD_IN = 280 * MiB;
constexpr size_t WS_WOD_OUT = 290 * MiB;
constexpr size_t WS_SGUW = 294 * MiB;
constexpr size_t WS_WC = 295 * MiB;
constexpr size_t WS_EOUT = 367 * MiB;
constexpr size_t WS_W1T = 392 * MiB;
constexpr size_t WS_SC1 = 648 * MiB;
constexpr size_t WS_SC2 = 660 * MiB;
constexpr size_t WS_SC3 = 664 * MiB;
constexpr int RT_PITCH = 2064;
constexpr size_t WS_RIMG = 666 * MiB;
constexpr size_t WS_B1H = 665 * MiB;
constexpr size_t WS_W2T = 904 * MiB;
constexpr size_t WS_PQT = 1160 * MiB;
constexpr size_t WS_UG = 1193 * MiB;
constexpr size_t WS_SLOC = 1283 * MiB;
constexpr size_t WS_YB = 1343 * MiB;
constexpr size_t WS_U = 1160 * MiB;
constexpr size_t WS_VS = 1193 * MiB;
constexpr size_t WS_Q = 1226 * MiB;
constexpr size_t WS_KALL = 1259 * MiB;
constexpr size_t WS_VT = 1292 * MiB;
constexpr size_t WS_TOKE = 1393 * MiB;
constexpr size_t WS_TOKS = 1394 * MiB;
constexpr size_t WS_TOKG = 1395 * MiB;
constexpr size_t WS_XR = 1396 * MiB;
constexpr size_t WS_INV = 1396 * MiB;
constexpr size_t WS_ACT = 1676 * MiB;
constexpr size_t WS_YR = 1956 * MiB;
constexpr size_t WS_DBG = 2236 * MiB;
constexpr size_t WS_END = 2240 * MiB;

constexpr int CW_TMO = 0, CW_CODE = 1;
constexpr int CW_BAR = 4096;
constexpr int CW_CNT = 16384;
constexpr int CW_CHK = 32768;

constexpr int RING_BYTES = 131072;
constexpr int TAB_OFF = 154112;
constexpr int MISC_OFF = 155136;
constexpr int LDS_BYTES = 155648;

DI unsigned f2bf(float f) { unsigned u = __builtin_bit_cast(unsigned, f); return (u + 0x7fffu + ((u >> 16) & 1u)) >> 16; }
DI unsigned pk2(float lo, float hi) { return f2bf(lo) | (f2bf(hi) << 16); }
DI float bf2f(unsigned b) { return __builtin_bit_cast(float, b << 16); }
DI float bflo(unsigned w) { return __builtin_bit_cast(float, w << 16); }
DI float bfhi(unsigned w) { return __builtin_bit_cast(float, w & 0xffff0000u); }
DI unsigned cvt_pk_bf16(float lo, float hi) { unsigned r; asm volatile("v_cvt_pk_bf16_f32 %0, %1, %2" : "=v"(r) : "v"(lo), "v"(hi)); return r; }
DI int lane_id() { int l; asm volatile("v_mbcnt_lo_u32_b32 %0, -1, 0\n\tv_mbcnt_hi_u32_b32 %0, -1, %0" : "=v"(l)); return l; }
template <class T> DI T my_shfl_idx(T v, int src) { return __builtin_bit_cast(T, __builtin_amdgcn_ds_bpermute(src << 2, __builtin_bit_cast(int, v))); }
template <class T> DI T my_shfl_xor(T v, int m) { return my_shfl_idx(v, lane_id() ^ m); }
template <class T> DI T my_shfl(T v, int src) { return my_shfl_idx(v, src); }
template <class T> DI T my_shfl_up(T v, int d, int w) { const int self = lane_id(); int idx = self - d; idx = idx < (self & ~(w - 1)) ? self : idx; return my_shfl_idx(v, idx); }
#define __shfl_xor my_shfl_xor
#define __shfl my_shfl
#define __shfl_up my_shfl_up
DI float wave_sum(float v) {
#pragma unroll
    for (int o = 1; o < 64; o <<= 1) v += __shfl_xor(v, o);
    return v;
}
template <int CTRL> DI float dpp_f(float v) { return __builtin_bit_cast(float, __builtin_amdgcn_update_dpp(0, __builtin_bit_cast(int, v), CTRL, 0xF, 0xF, true)); }
template <int MASK> DI float xor_lane(float v, int lane) {
    if constexpr (MASK == 1) return dpp_f<0xB1>(v);
    else if constexpr (MASK == 2) return dpp_f<0x4E>(v);
    else if constexpr (MASK == 4) return dpp_f<0x1B>(dpp_f<0x141>(v));
    else if constexpr (MASK == 8) return dpp_f<0x128>(v);
    else return __shfl_xor(v, MASK);
}
DI float fast_exp2(float x) { return __builtin_amdgcn_exp2f(x); }
DI float fast_rcp(float x) { return __builtin_amdgcn_rcpf(x); }
DI unsigned char f8_1(float a) { a = __builtin_amdgcn_fmed3f(a, -448.f, 448.f); return (unsigned char)(__builtin_amdgcn_cvt_pk_fp8_f32(a, a, 0, false) & 0xFF); }
DI unsigned pk4_fp8_nc(float a, float b, float c, float d) { int p = __builtin_amdgcn_cvt_pk_fp8_f32(a, b, 0, false); p = __builtin_amdgcn_cvt_pk_fp8_f32(c, d, p, true); return (unsigned)p; }
DI unsigned pk4_fp8(float a, float b, float c, float d) { a = __builtin_amdgcn_fmed3f(a, -448.f, 448.f); b = __builtin_amdgcn_fmed3f(b, -448.f, 448.f); c = __builtin_amdgcn_fmed3f(c, -448.f, 448.f); d = __builtin_amdgcn_fmed3f(d, -448.f, 448.f);
    int p = __builtin_amdgcn_cvt_pk_fp8_f32(a, b, 0, false); p = __builtin_amdgcn_cvt_pk_fp8_f32(c, d, p, true); return (unsigned)p; }
DI float sigmoidf_(float x) { return fast_rcp(1.f + fast_exp2(-1.4426950408889634f * x)); }
DI float gelu_tanh(float x) { const float C1 = -2.f * 0.7978845608028654f * 1.4426950408889634f, C2 = C1 * 0.044715f; return x * fast_rcp(1.f + fast_exp2(x * (x * x * C2 + C1))); }
DI float silu_(float x) { return x * sigmoidf_(x); }
#define LDS_WAIT() asm volatile("s_waitcnt lgkmcnt(0)" ::: "memory")
#define VM_WAIT() asm volatile("s_waitcnt vmcnt(0)" ::: "memory")

#define XB_TMO      128
#define XB_XCNT(j)  (256  + 64 * (j))
#define XB_XSUB(j)  (1280 + 64 * (j))
#define XB_XGEN(j)  (2304 + 64 * (j))
#define XB_TOP      3328
#define XB_TOPGEN   3392
#define XCD_BAR_WORDS 3456
#define XB_SPIN_CAP (1u << 18)
DI unsigned xb_ld(unsigned* p)              { return __hip_atomic_load(p, __ATOMIC_RELAXED, __HIP_MEMORY_SCOPE_AGENT); }
DI unsigned xb_add(unsigned* p, unsigned v) { return __hip_atomic_fetch_add(p, v, __ATOMIC_RELAXED, __HIP_MEMORY_SCOPE_AGENT); }
DI unsigned xb_xcc_id() { return (unsigned)__builtin_amdgcn_s_getreg((3 << 11) | 20) & 0xFu; }
#define XB_SPIN(cond, bar) do { unsigned _sp = 0; while (cond) { __builtin_amdgcn_s_sleep(1); \
    if ((++_sp & 255u) == 0u) { if (xb_ld(&(bar)[XB_TMO])) break; if (_sp > XB_SPIN_CAP) { atomicAdd(&(bar)[XB_TMO], 1u); break; } } } } while (0)
struct XcdBarrier { unsigned* bar; unsigned x; volatile LAS unsigned* st; int wv; };
DI XcdBarrier xcd_barrier_post(unsigned* bar, volatile LAS unsigned* st, int wv) {
    XcdBarrier b; b.bar = bar; b.x = xb_xcc_id(); b.st = st; b.wv = wv;
    if (wv == 0 && lane_id() == 0) (void)xb_add(&bar[XB_XCNT(b.x)], 1u);
    return b;
}
DI void xcd_barrier_complete(unsigned* bar, unsigned x, unsigned& nloc, unsigned& nx) {
    const unsigned G = gridDim.x * gridDim.y * gridDim.z;
    unsigned sum, cnt, mine, sp = 0u;
    for (;;) {
        sum = 0u; cnt = 0u; mine = 0u;
#pragma unroll
        for (unsigned j = 0; j < 16; ++j) { const unsigned c = xb_ld(&bar[XB_XCNT(j)]); sum += c; cnt += (c > 0u) ? 1u : 0u; mine = (j == x) ? c : mine; }
        if (sum == G) break;
        __builtin_amdgcn_s_sleep(1);
        if ((++sp & 255u) == 0u) { if (xb_ld(&bar[XB_TMO])) break; if (sp > XB_SPIN_CAP) { atomicAdd(&bar[XB_TMO], 1u); break; } }
    }
    nloc = mine > 0u ? mine : 1u; nx = cnt > 0u ? cnt : 1u;
}
DI void xcd_barrier(const XcdBarrier& b) {
    asm volatile("s_waitcnt vmcnt(0)" ::: "memory");
    __syncthreads();
    if (b.wv == 0 && lane_id() == 0) {
        unsigned* bar = b.bar;
        __builtin_amdgcn_s_waitcnt(0);
        unsigned nloc = b.st[0], nx = b.st[1];
        if (nloc == 0u) { xcd_barrier_complete(bar, b.x, nloc, nx); b.st[0] = nloc; b.st[1] = nx; }
        const unsigned old = xb_add(&bar[XB_XSUB(b.x)], 1u);
        const unsigned gen = old / nloc;
        if (old + 1u == (gen + 1u) * nloc) {
            __builtin_amdgcn_fence(__ATOMIC_RELEASE, "agent");
            asm volatile("s_waitcnt vmcnt(0)" ::: "memory");
            const unsigned og = xb_add(&bar[XB_TOP], 1u);
            const unsigned tg = og / nx;
            if (og + 1u == (tg + 1u) * nx) xb_add(&bar[XB_TOPGEN], 1u);
            else XB_SPIN(xb_ld(&bar[XB_TOPGEN]) == tg, bar);
            __builtin_amdgcn_fence(__ATOMIC_ACQUIRE, "agent");
            xb_add(&bar[XB_XGEN(b.x)], 1u);
            asm volatile("s_waitcnt vmcnt(0)" ::: "memory");
        } else {
            XB_SPIN(xb_ld(&bar[XB_XGEN(b.x)]) == gen, bar);
            __builtin_amdgcn_fence(__ATOMIC_ACQUIRE, "agent");
            asm volatile("s_waitcnt vmcnt(0)" ::: "memory");
        }
    }
    __syncthreads();
}

namespace pg8 {
constexpr int BM = 256, BK = 64, HALF = 128, HTB = HALF * BK * 2, STAGE_BYTES = 8 * HTB;
__host__ __device__ __forceinline__ int lds_byte(int r, int c) { const int st = (r >> 4) * 2 + (c >> 5), rr = r & 15, cc = c & 31, ob = rr * 64 + cc * 2; return st * 1024 + (ob ^ (((ob >> 9) & 1) << 5)); }
__host__ __device__ __forceinline__ void stage_rc(int b, int& R, int& C) { const int st = b / 1024, sb = b % 1024, swz = sb ^ (((sb >> 9) & 1) << 5); R = (st >> 1) * 16 + swz / 64; C = (st & 1) * 32 + (swz % 64) / 2; }
__host__ __device__ __forceinline__ int perm32(int rho) { const int n = rho >> 4, i = rho & 15; return 8 * (i >> 2) + 4 * n + (i & 3); }
struct Unit { const char* A; const char* B; int pm, pn, g, aux; const int* rowidx; int nvalid; const char* S; int half = 0, roff = 0; };
struct Gemm { int K, lda, ldb, wv; int kstepB = 128; };

DI unsigned ld_hidden(const char* base, unsigned off) { unsigned r; asm volatile("global_load_dword %0, %1, %2" : "=v"(r) : "v"(off), "s"(base) : "memory"); return r; }
template <int BYTE> DI void mfma_f8(f32x4& acc, const v8i w, const v8i x, unsigned sw, unsigned sx) {
    if constexpr (BYTE == 0) asm volatile("v_mfma_scale_f32_16x16x128_f8f6f4 %0, %1, %2, %0, %3, %4 op_sel_hi:[0,0,0]" : "+v"(acc) : "v"(w), "v"(x), "v"(sw), "v"(sx));
    else if constexpr (BYTE == 1) asm volatile("v_mfma_scale_f32_16x16x128_f8f6f4 %0, %1, %2, %0, %3, %4 op_sel:[1,0,0] op_sel_hi:[0,0,0]" : "+v"(acc) : "v"(w), "v"(x), "v"(sw), "v"(sx));
    else if constexpr (BYTE == 2) asm volatile("v_mfma_scale_f32_16x16x128_f8f6f4 %0, %1, %2, %0, %3, %4 op_sel_hi:[1,0,0]" : "+v"(acc) : "v"(w), "v"(x), "v"(sw), "v"(sx));
    else asm volatile("v_mfma_scale_f32_16x16x128_f8f6f4 %0, %1, %2, %0, %3, %4 op_sel:[1,0,0] op_sel_hi:[1,0,0]" : "+v"(acc) : "v"(w), "v"(x), "v"(sw), "v"(sx));
}
template <class Epi, class Sched, bool GATHER = false, bool F8 = false>
DI void gemm_phase(LAS unsigned char* lds, const Gemm g, const Sched& S, const Epi& E) {
    int tid_ = g.wv * 64 + lane_id(); asm volatile("" : "+v"(tid_));
    const int tid = tid_, wid = __builtin_amdgcn_readfirstlane(tid >> 6), lane = tid & 63, wr = wid >> 2, wc = wid & 3, fr = lane & 15, fq = lane >> 4;
    const int K = g.K, nt = K / BK;
    unsigned voffA[2], voffB[2];
#pragma unroll
    for (int i = 0; i < 2; ++i) { int R, C; stage_rc(tid * 16 + i * 8192, R, C); const int Rb = Epi::PERM ? ((R & ~31) + perm32(R & 31)) : R;
        voffA[i] = (unsigned)(R * g.lda + C) * 2u; voffB[i] = (unsigned)(Rb * g.ldb + C) * 2u; }
    const size_t kstep = (size_t)(BK * 2), kstepB = (size_t)g.kstepB;
    const size_t hstepA = GATHER ? (size_t)0 : (size_t)HALF * g.lda * 2, hstepB = (size_t)HALF * g.ldb * 2;
    int gR[2]; unsigned gC[2];
#pragma unroll
    for (int i = 0; i < 2; ++i) { int R, C; stage_rc(tid * 16 + i * 8192, R, C); gR[i] = R; gC[i] = (unsigned)C * 2u; }
    unsigned gcur[2][2], gnxt[2][2];
#define PG8_GRAW(dst, u) do { int t_ = tid; asm volatile("" : "+v"(t_));   \
        _Pragma("unroll") for (int h_ = 0; h_ < 2; ++h_) _Pragma("unroll") for (int i_ = 0; i_ < 2; ++i_) { int R_, C_; stage_rc(t_ * 16 + i_ * 8192, R_, C_); const int rr_ = (u).roff + h_ * HALF + R_; \
        dst[h_][i_] = ld_hidden((const char*)(u).rowidx, (unsigned)(rr_ < (u).nvalid ? rr_ : (u).nvalid - 1) * 4u); } } while (0)
#define PG8_GFIN(dst, src) do { _Pragma("unroll") for (int h_ = 0; h_ < 2; ++h_) _Pragma("unroll") for (int i_ = 0; i_ < 2; ++i_) dst[h_][i_] = (src[h_][i_] >> 2) * (unsigned)(g.lda * 2) + gC[i_]; } while (0)
    const unsigned ldsw = (unsigned)wid * 1024u;
    const int aoff = lds_byte(wr * 64 + fr, fq * 8), boff = lds_byte(wc * 32 + fr, fq * 8);
#define PG8_SA(b, h) (((b) * 2 + (h)) * HTB)
#define PG8_SB(b, h) ((4 + (b) * 2 + (h)) * HTB)
#define PG8_STAGE(bufoff, gbase, voff) do { _Pragma("unroll") for (int _i = 0; _i < 2; ++_i) \
        __builtin_amdgcn_global_load_lds((const unsigned*)((const char*)(gbase) + (voff)[_i]), (LAS unsigned*)(lds + (bufoff) + ldsw + _i * 8192), 16, 0, 0); } while (0)
#define PG8_STAGE_A(bufoff, gbase, h, OFFS) do { if constexpr (GATHER) { PG8_STAGE(bufoff, gbase, OFFS[h]); } else { PG8_STAGE(bufoff, (gbase) + (h) * hstepA, voffA); } } while (0)
#define PG8_LDA(dst, b, h) do { _Pragma("unroll") for (int m = 0; m < 4; ++m) _Pragma("unroll") for (int k = 0; k < 2; ++k) dst[m][k] = *(const LAS bf16x8*)(lds + PG8_SA(b, h) + aoff + m * 2048 + k * 1024); } while (0)
#define PG8_LDB(dst, b, h) do { _Pragma("unroll") for (int n = 0; n < 2; ++n) _Pragma("unroll") for (int k = 0; k < 2; ++k) dst[n][k] = *(const LAS bf16x8*)(lds + PG8_SB(b, h) + boff + n * 2048 + k * 1024); } while (0)
#define PG8_CAT(x) __builtin_shufflevector(__builtin_bit_cast(v4i, x[0]), __builtin_bit_cast(v4i, x[1]), 0, 1, 2, 3, 4, 5, 6, 7)
#define PG8_MMA(ai, bj, At, Bt, SW) do { __builtin_amdgcn_s_setprio(1); _Pragma("unroll") for (int m = 0; m < 4; ++m) { \
        if constexpr (F8) { mfma_f8<(bj) * 2 + 0>(acc[ai][bj][m][0], PG8_CAT(Bt[0]), PG8_CAT(At[m]), SW, 0x7F7F7F7Fu); mfma_f8<(bj) * 2 + 1>(acc[ai][bj][m][1], PG8_CAT(Bt[1]), PG8_CAT(At[m]), SW, 0x7F7F7F7Fu); } \
        else { _Pragma("unroll") for (int n = 0; n < 2; ++n) _Pragma("unroll") for (int k = 0; k < 2; ++k) acc[ai][bj][m][n] = __builtin_amdgcn_mfma_f32_16x16x32_bf16(Bt[n][k], At[m][k], acc[ai][bj][m][n], 0, 0, 0); } } __builtin_amdgcn_s_setprio(0); } while (0)
#define PG8_WAIT_V(n) asm volatile("s_waitcnt vmcnt(" #n ")" ::: "memory")
#define PG8_WAIT_VF(n) do { if constexpr (F8) asm volatile("s_waitcnt vmcnt(9)" ::: "memory"); else asm volatile("s_waitcnt vmcnt(" #n ")" ::: "memory"); } while (0)
#define PG8_WAIT_VG(n) do { if (GATHER && has_next && t == 0) { if constexpr (F8) asm volatile("s_waitcnt vmcnt(13)" ::: "memory"); else asm volatile("s_waitcnt vmcnt(12)" ::: "memory"); } else PG8_WAIT_VF(n); } while (0)
#define PG8_WAIT_L(n) asm volatile("s_waitcnt lgkmcnt(" #n ")" ::: "memory")
#define PG8_BAR __builtin_amdgcn_s_barrier()
#define PG8_SCHED __builtin_amdgcn_sched_barrier(0)
    const unsigned sc_lane = (unsigned)(wc * 64 + lane) * 8u;
    unsigned scx = 0x7F7F7F7Fu, scy = 0x7F7F7F7Fu;
    Unit cur, nxt; int ui = 0;
    if (!S.next(0, cur)) return;
    f32x4 acc[2][2][4][2];
    v2u bnx[2][2];
#pragma unroll
    for (int b = 0; b < 2; ++b)
#pragma unroll
        for (int n = 0; n < 2; ++n) bnx[b][n] = (v2u){0u, 0u};
#pragma unroll
    for (int a = 0; a < 2; ++a)
#pragma unroll
        for (int b = 0; b < 2; ++b)
#pragma unroll
            for (int m = 0; m < 4; ++m)
#pragma unroll
                for (int n = 0; n < 2; ++n) acc[a][b][m][n] = (f32x4){bflo(bnx[b][n].x), bfhi(bnx[b][n].x), bflo(bnx[b][n].y), bfhi(bnx[b][n].y)} + (b ? Epi::BIAS1_ADD : 0.f);
    bf16x8 At[4][2], B0[2][2], B1[2][2];
    const char* cA = cur.A; const char* cB = cur.B; const char* cS = cur.S;
    if constexpr (F8) scx = ld_hidden(cS, sc_lane);
    if constexpr (GATHER) { PG8_GRAW(gnxt, cur); asm volatile("s_waitcnt vmcnt(0)" : "+v"(gnxt[0][0]), "+v"(gnxt[0][1]), "+v"(gnxt[1][0]), "+v"(gnxt[1][1]) :: "memory"); PG8_GFIN(gcur, gnxt); }
    PG8_STAGE(PG8_SB(0, 0), cB, voffB); PG8_STAGE(PG8_SB(0, 1), cB + hstepB, voffB); PG8_STAGE_A(PG8_SA(0, 0), cA, 0, gcur); PG8_STAGE_A(PG8_SA(0, 1), cA, 1, gcur);
    if (wr == 1) PG8_BAR;
    PG8_WAIT_V(2); PG8_BAR;
    PG8_STAGE(PG8_SB(1, 0), cB + kstepB, voffB); PG8_STAGE_A(PG8_SA(1, 0), cA + kstep, 0, gcur); PG8_STAGE(PG8_SB(1, 1), cB + hstepB + kstepB, voffB);
    PG8_WAIT_V(6); PG8_BAR;
    if constexpr (Epi::BIAS_INIT) { E.load_bias(cur, wc, fq, bnx);
#pragma unroll
        for (int a = 0; a < 2; ++a)
#pragma unroll
            for (int b = 0; b < 2; ++b)
#pragma unroll
                for (int m = 0; m < 4; ++m)
#pragma unroll
                    for (int n = 0; n < 2; ++n) acc[a][b][m][n] = (f32x4){bflo(bnx[b][n].x), bfhi(bnx[b][n].x), bflo(bnx[b][n].y), bfhi(bnx[b][n].y)} + (b ? Epi::BIAS1_ADD : 0.f); }
    for (;;) {
        const bool has_next = S.next(ui + 1, nxt);
        const char* nA = has_next ? nxt.A : cA; const char* nB = has_next ? nxt.B : cB; const char* nS = has_next ? nxt.S : cS;
        if constexpr (GATHER) { if (has_next) { PG8_GRAW(gnxt, nxt); } }
        unsigned g2[2][2];
#pragma unroll 1
        for (int t = 0; t < nt; t += 2) {
            const bool last = (t == nt - 2);
            const char* a1 = cA + (size_t)(t + 1) * kstep;
            const char* a2 = last ? nA : cA + (size_t)(t + 2) * kstep; const char* b2 = last ? nB : cB + (size_t)(t + 2) * kstepB;
            const char* a3 = a2 + kstep; const char* b3 = b2 + kstepB;
            if constexpr (GATHER) {
                if (last && has_next) { asm volatile("" : "+v"(gnxt[0][0]), "+v"(gnxt[0][1]), "+v"(gnxt[1][0]), "+v"(gnxt[1][1]));
                    PG8_GFIN(g2, gnxt);
                } else {
#pragma unroll
                    for (int h_ = 0; h_ < 2; ++h_)
#pragma unroll
                        for (int i_ = 0; i_ < 2; ++i_) g2[h_][i_] = gcur[h_][i_]; } }
            PG8_LDB(B0, 0, 0); PG8_LDB(B1, 0, 1); PG8_SCHED; PG8_LDA(At, 0, 0); PG8_STAGE_A(PG8_SA(1, 1), a1, 1, gcur);
            if constexpr (F8) scy = ld_hidden(cS + (size_t)(t >> 1) * 2048 + 4, sc_lane);
            PG8_WAIT_VG(8); PG8_WAIT_L(0); PG8_BAR; PG8_MMA(0, 0, At, B0, scx); PG8_MMA(0, 1, At, B1, scx); PG8_BAR; PG8_SCHED;
            PG8_LDA(At, 0, 1); PG8_STAGE(PG8_SB(0, 0), b2, voffB); PG8_STAGE(PG8_SB(0, 1), b2 + hstepB, voffB); PG8_STAGE_A(PG8_SA(0, 0), a2, 0, g2);
            PG8_WAIT_VG(8); PG8_WAIT_L(0); PG8_BAR; if (!cur.half) { PG8_MMA(1, 0, At, B0, scx); PG8_MMA(1, 1, At, B1, scx); } PG8_BAR; PG8_SCHED;
            PG8_LDB(B0, 1, 0); PG8_LDB(B1, 1, 1); PG8_SCHED; PG8_LDA(At, 1, 0); PG8_STAGE_A(PG8_SA(0, 1), a2, 1, g2);
            if constexpr (F8) { const char* sp = last ? nS : cS + (size_t)((t >> 1) + 1) * 2048; scx = ld_hidden(sp, sc_lane); }
            PG8_WAIT_VF(8); PG8_WAIT_L(0); PG8_BAR; PG8_MMA(0, 0, At, B0, scy); PG8_MMA(0, 1, At, B1, scy); PG8_BAR; PG8_SCHED;
            PG8_LDA(At, 1, 1); PG8_STAGE(PG8_SB(1, 0), b3, voffB); PG8_STAGE(PG8_SB(1, 1), b3 + hstepB, voffB); PG8_STAGE_A(PG8_SA(1, 0), a3, 0, g2);
            PG8_WAIT_VF(8); PG8_WAIT_L(0); PG8_BAR; if (!cur.half) { PG8_MMA(1, 0, At, B0, scy); PG8_MMA(1, 1, At, B1, scy); } PG8_BAR; PG8_SCHED;
        }
        if constexpr (F8) asm volatile("s_nop 15\n\ts_nop 15" ::: "memory");
        if (wr == 0) PG8_BAR;
        if constexpr (Epi::BIAS_INIT) { if (has_next) E.load_bias(nxt, wc, fq, bnx); }
        E(acc, cur, wr, wc, fr, fq);
        if (!has_next) break;
#pragma unroll
        for (int a = 0; a < 2; ++a)
#pragma unroll
            for (int b = 0; b < 2; ++b)
#pragma unroll
                for (int m = 0; m < 4; ++m)
#pragma unroll
                    for (int n = 0; n < 2; ++n) acc[a][b][m][n] = (f32x4){bflo(bnx[b][n].x), bfhi(bnx[b][n].x), bflo(bnx[b][n].y), bfhi(bnx[b][n].y)} + (b ? Epi::BIAS1_ADD : 0.f);
        cur = nxt; cA = nA; cB = nB; cS = nS; ++ui;
        if constexpr (GATHER) {
#pragma unroll
            for (int h_ = 0; h_ < 2; ++h_)
#pragma unroll
                for (int i_ = 0; i_ < 2; ++i_) gcur[h_][i_] = g2[h_][i_]; }
        if (wr == 1) PG8_BAR;
    }
    PG8_WAIT_V(0);
    PG8_BAR;
#undef PG8_SA
#undef PG8_SB
#undef PG8_STAGE
#undef PG8_STAGE_A
#undef PG8_GRAW
#undef PG8_GFIN
#undef PG8_LDA
#undef PG8_LDB
#undef PG8_MMA
#undef PG8_CAT
#undef PG8_WAIT_V
#undef PG8_WAIT_VF
#undef PG8_WAIT_VG
#undef PG8_WAIT_L
#undef PG8_BAR
#undef PG8_SCHED
}
}
struct Args { const float* in[38]; float* out; unsigned char* ws; int ph_lo, ph_hi, rep, pad; };
typedef const __attribute__((address_space(4))) Args* CArgsP;
DI CArgsP kargs() { CArgsP p = (CArgsP)__builtin_amdgcn_kernarg_segment_ptr(); asm volatile("" : "+s"(p)); return p; }
struct Frame {
    LAS unsigned char* lds;
    volatile LAS unsigned* MISC;
    gu32* ctl;
    unsigned char* ws;
    int tid, lane, wave, G, vcu;
};
DI unsigned char* WSP(const Frame& F) { unsigned char* p = F.ws; asm volatile("" : "+s"(p)); return p; }
DI Frame refresh(const Frame& G) { Frame F = G; int t = G.wave * 64 + lane_id(); asm volatile("" : "+v"(t)); F.tid = t; F.lane = t & 63; F.wave = G.wave;
    unsigned char* w = G.ws; asm volatile("" : "+s"(w)); F.ws = w; return F; }
enum { I_X = 0, I_C, I_CTX, I_CCTX, I_ADAW, I_ADAB, I_N1G, I_N2G, I_EVWIN, I_EVWOUT, I_LAMRE, I_LAMIM, I_LOGSTEP, I_BRE, I_BIM, I_CRE, I_CIM, I_S5D, I_GLUW, I_GLUB,
       I_ODWIN, I_ODWOUT, I_SGULNG, I_SGULNB, I_SGUW, I_SGUB, I_LQ1, I_LK1, I_LQ2, I_LK2, I_SUBLN, I_RW, I_RB, I_W1, I_B1, I_W2, I_B2, I_FING };

DI void transpose_tile(const float* W, int N, int k0, int n0, bf16* WT, int Kd, int dst_row0, LAS float* scr, int lane) {
    f32x4 v[16];
#pragma unroll
    for (int i = 0; i < 16; ++i) v[i] = *(const GAS f32x4*)(W + (size_t)(k0 + 4 * i + (lane >> 4)) * N + n0 + 4 * (lane & 15));
#pragma unroll
    for (int i = 0; i < 16; ++i) { LAS float* d = scr + (4 * i + (lane >> 4)) * 65 + 4 * (lane & 15); d[0] = v[i].x; d[1] = v[i].y; d[2] = v[i].z; d[3] = v[i].w; }
    LDS_WAIT(); asm volatile("" ::: "memory");
    const int c = lane & 7;
#pragma unroll
    for (int j = 0; j < 8; ++j) { const int n = (lane >> 3) + 8 * j; const LAS float* s = scr + (8 * c) * 65 + n;
        v4u o; o.x = pk2(s[0], s[65]); o.y = pk2(s[130], s[195]); o.z = pk2(s[260], s[325]); o.w = pk2(s[390], s[455]);
        *(GAS v4u*)(WT + (size_t)(dst_row0 + n) * Kd + k0 + 8 * c) = o; }
    LDS_WAIT(); asm volatile("" ::: "memory");
}

DI void transpose_tile_f8(const float* W, int N, int k0, int n0, unsigned char* dst, unsigned char* sc, int kb, int r0, LAS float* scr, int lane) {
    f32x4 v[16];
#pragma unroll
    for (int i = 0; i < 16; ++i) v[i] = *(const GAS f32x4*)(W + (size_t)(k0 + 4 * i + (lane >> 4)) * N + n0 + 4 * (lane & 15));
#pragma unroll
    for (int i = 0; i < 16; ++i) { LAS float* d = scr + (4 * i + (lane >> 4)) * 65 + 4 * (lane & 15); d[0] = v[i].x; d[1] = v[i].y; d[2] = v[i].z; d[3] = v[i].w; }
    LDS_WAIT(); asm volatile("" ::: "memory");
    const int c = lane & 7, T = kb >> 1, blk = 2 * (kb & 1) + (c >> 2);
#pragma unroll
    for (int j = 0; j < 8; ++j) { const int n = (lane >> 3) + 8 * j; const LAS float* s = scr + (8 * c) * 65 + n;
        float x[8];
#pragma unroll
        for (int e = 0; e < 8; ++e) x[e] = s[65 * e];
        float am = fmaxf(fmaxf(fmaxf(fabsf(x[0]), fabsf(x[1])), fmaxf(fabsf(x[2]), fabsf(x[3]))), fmaxf(fmaxf(fabsf(x[4]), fabsf(x[5])), fmaxf(fabsf(x[6]), fabsf(x[7]))));
        am = fmaxf(am, xor_lane<1>(am, lane)); am = fmaxf(am, xor_lane<2>(am, lane));
        const unsigned ab = __builtin_bit_cast(unsigned, am);
        int sb = (int)(ab >> 23) - 8 + ((ab & 0x7FFFFFu) > 0x600000u ? 1 : 0);
        sb = sb < 1 ? 1 : (sb > 253 ? 253 : sb);
        const float mul = __builtin_bit_cast(float, (unsigned)(254 - sb) << 23);
        v2u o; o.x = pk4_fp8(x[0] * mul, x[1] * mul, x[2] * mul, x[3] * mul); o.y = pk4_fp8(x[4] * mul, x[5] * mul, x[6] * mul, x[7] * mul);
        *(GAS v2u*)(dst + (size_t)n * 128 + 64 * (kb & 1) + 8 * c) = o;
        if ((c & 3) == 0) { const int r = r0 + n, r32 = r & 31;
            sc[(size_t)((((T >> 1) * 4 + ((r >> 5) & 3)) * 64 + blk * 16 + 4 * (r32 >> 3) + (r32 & 3)) * 8 + (T & 1) * 4 + (r >> 7) * 2 + ((r32 >> 2) & 1))] = (unsigned char)sb; }
    }
    LDS_WAIT(); asm volatile("" ::: "memory");
}

DI void mod_item(Frame& F, CArgsP a, int item) {
    unsigned char* const ws = WSP(F);
    LAS float* sv = (LAS float*)F.lds;
    LAS float* part = sv + 5 * 1024;
    const int layer = item / 96, cg = item % 96, col = cg * 64 + F.lane;
    for (int i = F.tid; i < 5 * 1024; i += 512) { const int v = i >> 10, k = i & 1023; const float x = v < 4 ? a->in[I_C][v * 1024 + k] : a->in[I_CCTX][k]; sv[i] = silu_(x); }
    __syncthreads();
    const float* W = a->in[I_ADAW] + (size_t)layer * 1024 * 6144 + col;
    float acc[5] = {0.f, 0.f, 0.f, 0.f, 0.f};
    const int kb = F.wave * 128;
#pragma unroll 32
    for (int k = 0; k < 128; ++k) { const float w = W[(size_t)(kb + k) * 6144];
#pragma unroll
        for (int v = 0; v < 5; ++v) acc[v] += sv[v * 1024 + kb + k] * w; }
#pragma unroll
    for (int v = 0; v < 5; ++v) part[(F.wave * 5 + v) * 64 + F.lane] = acc[v];
    __syncthreads();
    if (F.tid < 320) { const int v = F.tid >> 6, l = F.tid & 63; float s = 0.f;
#pragma unroll
        for (int w = 0; w < 8; ++w) s += part[(w * 5 + v) * 64 + l];
        const int c2 = cg * 64 + l;
        ((float*)(ws + WS_MOD))[(size_t)(layer * 5 + v) * 6144 + c2] = s + a->in[I_ADAB][layer * 6144 + c2]; }
    __syncthreads();
}

DI void s5mat_item(Frame& F, CArgsP a, int item) {
    unsigned char* const ws = WSP(F);
    const int j = item / 48, g = item % 48;
    LAS float* apw = (LAS float*)F.lds;
    LAS float* bb = apw + 2 * 64 * 33 * 2;
    LAS float* cm = bb + 2 * 64 * 16 * 2;
    LAS float* kk = cm + 2 * 16 * 64 * 2;
    LAS float* dd = kk + 2 * 32 * 256;
    for (int i = F.tid; i < 2 * 64; i += 512) { const int dir = i >> 6, n = i & 63;
        const size_t p = ((size_t)(j * 2 + dir) * 48 + g) * 64 + n;
        const float lre = a->in[I_LAMRE][p], lim = a->in[I_LAMIM][p], step = expf(a->in[I_LOGSTEP][(j * 2 + dir) * 48 + g]);
        for (int tau = 0; tau <= 32; ++tau) { const float mag = expf(lre * step * tau), ang = lim * step * tau; apw[(i * 33 + tau) * 2] = mag * cosf(ang); apw[(i * 33 + tau) * 2 + 1] = mag * sinf(ang); }
        const float ar = apw[(i * 33 + 1) * 2] - 1.f, ai = apw[(i * 33 + 1) * 2 + 1];
        const float den = 1.f / (lre * lre + lim * lim), qr = (ar * lre + ai * lim) * den, qi = (ai * lre - ar * lim) * den;
        for (int c = 0; c < 16; ++c) { const float br = a->in[I_BRE][p * 16 + c], bi = a->in[I_BIM][p * 16 + c]; bb[(i * 16 + c) * 2] = qr * br - qi * bi; bb[(i * 16 + c) * 2 + 1] = qr * bi + qi * br; }
        ((float*)(ws + WS_APT))[p * 2] = apw[(i * 33 + 32) * 2]; ((float*)(ws + WS_APT))[p * 2 + 1] = apw[(i * 33 + 32) * 2 + 1];
    }
    for (int i = F.tid; i < 2 * 16 * 64; i += 512) { const int dir = i >> 10, c = (i >> 6) & 15, n = i & 63; const size_t p = (((size_t)(j * 2 + dir) * 48 + g) * 16 + c) * 64 + n;
        cm[i * 2] = a->in[I_CRE][p]; cm[i * 2 + 1] = a->in[I_CIM][p]; }
    if (F.tid < 16) dd[F.tid] = a->in[I_S5D][(j * 48 + g) * 16 + F.tid];
    __syncthreads();
    for (int i = F.tid; i < 2 * 32 * 16; i += 512) { const int dir = i >> 9, tau = (i >> 4) & 31, c = i & 15;
        float s[16];
#pragma unroll
        for (int q = 0; q < 16; ++q) s[q] = 0.f;
#pragma unroll 2
        for (int n = 0; n < 64; ++n) { const f32x2 cv = *(const LAS f32x2*)(cm + ((dir * 16 + c) * 64 + n) * 2), av = *(const LAS f32x2*)(apw + ((dir * 64 + n) * 33 + tau) * 2);
            const float gr = cv.x * av.x - cv.y * av.y, gi = cv.x * av.y + cv.y * av.x;
            const LAS f32x4* bp = (const LAS f32x4*)(bb + (dir * 64 + n) * 32);
#pragma unroll
            for (int q = 0; q < 8; ++q) { const f32x4 b = bp[q]; s[2 * q] += gr * b.x - gi * b.y; s[2 * q + 1] += gr * b.z - gi * b.w; } }
#pragma unroll
        for (int q = 0; q < 16; ++q) kk[((dir * 32 + tau) * 16 + c) * 16 + q] = s[q]; }
    __syncthreads();
    bf16* Wc = (bf16*)(ws + WS_WC) + (size_t)(j * 48 + g) * 512 * 768;
    for (int i = F.tid; i < 512 * 768 / 2; i += 512) { const int row = i / 384, k0 = (i % 384) * 2; const int t = row >> 4, c = row & 15; float v[2];
#pragma unroll
        for (int e = 0; e < 2; ++e) { const int k = k0 + e; float x;
            if (k < 512) { const int s = k >> 4, c2 = k & 15; x = 0.f;
                if (s <= t) x += kk[((0 * 32 + (t - s)) * 16 + c) * 16 + c2];
                if (s >= t) x += kk[((1 * 32 + (s - t)) * 16 + c) * 16 + c2];
                if (s == t && c == c2) x += dd[c];
            } else { const int q = k - 512, dir = q >> 7, n = (q >> 1) & 63, ri = q & 1; const int tau = dir ? (32 - t) : (t + 1);
                const float cr = cm[((dir * 16 + c) * 64 + n) * 2], ci = cm[((dir * 16 + c) * 64 + n) * 2 + 1];
                const float ar = apw[((dir * 64 + n) * 33 + tau) * 2], ai = apw[((dir * 64 + n) * 33 + tau) * 2 + 1];
                x = ri ? -(cr * ai + ci * ar) : (cr * ar - ci * ai); }
            v[e] = x; }
        *(GAS unsigned*)(Wc + (size_t)row * 768 + k0) = pk2(v[0], v[1]); }
    bf16* Eo = (bf16*)(ws + WS_EOUT) + (size_t)(j * 48 + g) * 256 * 512;
    for (int i = F.tid; i < 256 * 512 / 2; i += 512) { const int row = i >> 8, k0 = (i & 255) * 2; const int dir = row >> 7, n = (row >> 1) & 63, ri = row & 1; float v[2];
#pragma unroll
        for (int e = 0; e < 2; ++e) { const int k = k0 + e, t = k >> 4, c = k & 15; const int tau = dir ? t : (31 - t);
            const float ar = apw[((dir * 64 + n) * 33 + tau) * 2], ai = apw[((dir * 64 + n) * 33 + tau) * 2 + 1];
            const float br = bb[((dir * 64 + n) * 16 + c) * 2], bi = bb[((dir * 64 + n) * 16 + c) * 2 + 1];
            v[e] = ri ? (ar * bi + ai * br) : (ar * br - ai * bi); }
        *(GAS unsigned*)(Eo + (size_t)row * 512 + k0) = pk2(v[0], v[1]); }
    __syncthreads();
}

DI void wpq_item(Frame& F, CArgsP a, int item, LAS float* scr) {
    unsigned char* const ws = WSP(F);
    const int j = item >> 6, g = (item >> 4) & 3, k0 = (item & 15) * 64;
    const float* W = a->in[I_EVWIN] + (size_t)j * 1024 * 1024;
#pragma unroll 4
    for (int i = 0; i < 64; ++i) scr[i * 65 + F.lane] = W[(size_t)(k0 + i) * 1024 + g * 64 + F.lane];
    LDS_WAIT(); asm volatile("" ::: "memory");
    bf16* O = (bf16*)(ws + WS_WEV_PQ) + (size_t)j * 512 * 1024;
    const LAS float* row = scr + F.lane * 65; const LAS float* trig = (const LAS float*)(F.lds + 133120);
    for (int m = 0; m < 64; ++m) { float p = 0.f, q = 0.f;
#pragma unroll 8
        for (int c = 0; c < 64; ++c) { const int r = (m * c) & 63; p += row[c] * trig[r]; q += row[c] * trig[64 + r]; }
        O[(size_t)(g * 64 + m) * 1024 + k0 + F.lane] = (bf16)f2bf(p); O[(size_t)(256 + g * 64 + m) * 1024 + k0 + F.lane] = (bf16)f2bf(q); }
    LDS_WAIT(); asm volatile("" ::: "memory");
}

DI void prologue0(Frame& F, CArgsP a) {
    unsigned char* const ws = WSP(F);
    for (int it = F.vcu; it < 384 + 96; it += F.G) { if (it < 384) mod_item(F, a, it); else s5mat_item(F, a, it - 384); }
    if (F.tid < 64) { LAS float* trig = (LAS float*)(F.lds + 133120); trig[F.tid] = cospif((float)F.tid * (1.f / 32.f)); trig[64 + F.tid] = sinpif((float)F.tid * (1.f / 32.f)); }
    __syncthreads();
    const int gw = F.vcu * 8 + F.wave, NGW = F.G * 8;
    LAS float* scr = (LAS float*)(F.lds + F.wave * 16640);
    for (int i = gw * 64 + F.lane; i < 128 * 16; i += NGW * 64) { const int pos = i >> 4, f = i & 15; const float inv = powf(10000.f, -(float)(2 * f) / 32.f), ang = (float)pos * inv;
        ((float*)(ws + WS_ROPE))[i * 2] = cosf(ang); ((float*)(ws + WS_ROPE))[i * 2 + 1] = sinf(ang); }
    for (int i = gw * 64 + F.lane; i < 4096; i += NGW * 64) { ((float*)(ws + WS_TW))[i * 2] = cospif((float)i * (1.f / 4096.f)); ((float*)(ws + WS_TW))[i * 2 + 1] = -sinpif((float)i * (1.f / 4096.f)); }
    for (int i = gw * 64 + F.lane; i < 4 * 32768; i += NGW * 64) { const int layer = i >> 15, q = i & 32767, k = q >> 5, e = q & 31; const float v = a->in[I_RW][i];
        const unsigned hi = f2bf(v), lo = f2bf(v - bf2f(hi)); unsigned char* img = ws + WS_RIMG + (size_t)layer * (64 * RT_PITCH);
        *(bf16*)(img + e * RT_PITCH + k * 2) = (bf16)hi; *(bf16*)(img + (32 + e) * RT_PITCH + k * 2) = (bf16)lo; }
    for (int i = gw * 64 + F.lane; i < (4 * 32 * 2048 + 4 * 32 * 1024 + 2 * 768) / 4; i += NGW * 64) { const float* src; bf16* dst; int o = i * 4;
        if (o < 4 * 32 * 2048) { src = a->in[I_B1] + o; dst = (bf16*)(ws + WS_B1H) + o; } else { o -= 4 * 32 * 2048;
            if (o < 4 * 32 * 1024) { src = a->in[I_B2] + o; dst = (bf16*)(ws + WS_B1H + 512 * 1024) + o; } else { o -= 4 * 32 * 1024; src = a->in[I_GLUB] + o; dst = (bf16*)(ws + WS_B1H + 768 * 1024) + o; } }
        const f32x4 v = *(const GAS f32x4*)src; v2u w; w.x = pk2(v.x, v.y); w.y = pk2(v.z, v.w); *(GAS v2u*)dst = w; }
    if (gw < 2) { const int jl = gw, layer = 2 * jl + 1; const float d1 = wave_sum(a->in[I_LQ1][jl * 64 + F.lane] * a->in[I_LK1][jl * 64 + F.lane]), d2 = wave_sum(a->in[I_LQ2][jl * 64 + F.lane] * a->in[I_LK2][jl * 64 + F.lane]);
        const float lam_init = 0.8f - 0.6f * expf(-0.3f * (float)layer);
        if (F.lane == 0) { ((float*)(ws + WS_CB))[jl * 2] = expf(d1) - expf(d2) + lam_init; ((float*)(ws + WS_CB))[jl * 2 + 1] = lam_init; } }
    for (int i = gw * 64 + F.lane; i < 2 * 4 * 128 * 128 / 4; i += NGW * 64) { const f32x4 v = ((const GAS f32x4*)a->in[I_SGUW])[i]; v2u o; o.x = pk2(v.x, v.y); o.y = pk2(v.z, v.w); ((GAS v2u*)(ws + WS_SGUW))[i] = o; }
    constexpr int T_EVS5 = 2 * 16 * 12, T_EVOUT = 2 * 16 * 16, T_GLU = 2 * 12 * 12, T_ODIN = 2 * 16 * 40, T_ODOUT = 2 * 16 * 16, T_W1 = 128 * 16 * 32, T_W2 = 128 * 16 * 16, T_WPQ = 128;
    constexpr int T_ALL = T_EVS5 + T_EVOUT + T_GLU + T_ODIN + T_ODOUT + T_W1 + T_W2 + T_WPQ;
    for (int it = gw; it < T_ALL; it += NGW) {
        int r = it;
        if (r < T_WPQ) { wpq_item(F, a, r, scr); continue; } r -= T_WPQ;
        if (r < T_EVS5) { const int j = r / 192, q = r % 192, kb = q / 12, nb = q % 12;
            transpose_tile(a->in[I_EVWIN] + (size_t)j * 1048576, 1024, kb * 64, 256 + nb * 64, (bf16*)(ws + WS_WEV_S5) + (size_t)j * 768 * 1024, 1024, nb * 64, scr, F.lane); continue; } r -= T_EVS5;
        if (r < T_EVOUT) { const int j = r / 256, q = r % 256, kb = q / 16, nb = q % 16;
            { const int drow = nb * 64; transpose_tile_f8(a->in[I_EVWOUT] + (size_t)j * 1048576, 1024, kb * 64, nb * 64, ws + WS_WEV_OUT + (size_t)j * 1048576 + ((size_t)((drow >> 8) * 8 + (kb >> 1)) * 256 + (drow & 255)) * 128, ws + WS_SC3 + (size_t)j * 32768 + (size_t)(drow >> 8) * 8192, kb, drow & 255, scr, F.lane); } continue; } r -= T_EVOUT;
        if (r < T_GLU) { const int j = r / 144, q = r % 144, kb = q / 12, nb = q % 12;
            transpose_tile(a->in[I_GLUW] + (size_t)j * 768 * 768, 768, kb * 64, nb * 64, (bf16*)(ws + WS_GLUW) + (size_t)j * 768 * 768, 768, nb * 64, scr, F.lane); continue; } r -= T_GLU;
        if (r < T_ODIN) { const int j = r / 640, q = r % 640, kb = q / 40, nb = q % 40;
            transpose_tile(a->in[I_ODWIN] + (size_t)j * 1024 * 2560, 2560, kb * 64, nb * 64, (bf16*)(ws + WS_WOD_IN) + (size_t)j * 2560 * 1024, 1024, nb * 64, scr, F.lane); continue; } r -= T_ODIN;
        if (r < T_ODOUT) { const int j = r / 256, q = r % 256, kb = q / 16, nb = q % 16;
            { const int drow = nb * 64; transpose_tile_f8(a->in[I_ODWOUT] + (size_t)j * 1048576, 1024, kb * 64, nb * 64, ws + WS_WOD_OUT + (size_t)j * 1048576 + ((size_t)((drow >> 8) * 8 + (kb >> 1)) * 256 + (drow & 255)) * 128, ws + WS_SC3 + 65536 + (size_t)j * 32768 + (size_t)(drow >> 8) * 8192, kb, drow & 255, scr, F.lane); } continue; } r -= T_ODOUT;
        if (r < T_W1) { const int le = r / 512, q = r % 512, kb = q / 32, nb = q % 32;
            const int n0 = nb * 64, half = n0 >> 10, nn = n0 & 1023, drow = 256 * (nn >> 7) + 128 * half + (nn & 127);
            transpose_tile_f8(a->in[I_W1] + (size_t)le * 1024 * 2048, 2048, kb * 64, n0, ws + WS_W1T + (size_t)le * 2048 * 1024 + ((size_t)((drow >> 8) * 8 + (kb >> 1)) * 256 + (drow & 255)) * 128, ws + WS_SC1 + (size_t)le * 65536 + (size_t)(drow >> 8) * 8192, kb, drow & 255, scr, F.lane); continue; } r -= T_W1;
        { const int le = r / 256, q = r % 256, kb = q / 16, nb = q % 16; const int drow = nb * 64;
            transpose_tile_f8(a->in[I_W2] + (size_t)le * 1048576, 1024, kb * 64, nb * 64, ws + WS_W2T + (size_t)le * 1048576 + ((size_t)((drow >> 8) * 8 + (kb >> 1)) * 256 + (drow & 255)) * 128, ws + WS_SC2 + (size_t)le * 32768 + (size_t)(drow >> 8) * 8192, kb, drow & 255, scr, F.lane); }
    }
}

DI int mod_row(int row) { return row < NLAT ? (row >> 13) : 4; }

DI void norm_mod_row(const float* src, bf16* hcopy, const float* gvec, const float* shift, const float* scale, bf16* dst, int lane) {
    f32x4 v[4]; float s = 0.f;
#pragma unroll
    for (int j = 0; j < 4; ++j) { v[j] = ((const GAS f32x4*)src)[lane + 64 * j]; s += (v[j].x * v[j].x + v[j].y * v[j].y) + (v[j].z * v[j].z + v[j].w * v[j].w); }
    if (hcopy) {
#pragma unroll
        for (int j = 0; j < 4; ++j) { v2u o; o.x = pk2(v[j].x, v[j].y); o.y = pk2(v[j].z, v[j].w); ((GAS v2u*)hcopy)[lane + 64 * j] = o; } }
    const float rstd = 1.f / sqrtf(wave_sum(s) * (1.f / 1024.f) + EPS);
#pragma unroll
    for (int j = 0; j < 4; ++j) { const f32x4 g = ((const GAS f32x4*)gvec)[lane + 64 * j], sh = ((const GAS f32x4*)shift)[lane + 64 * j], sc = ((const GAS f32x4*)scale)[lane + 64 * j];
        const f32x4 y = v[j] * rstd * g * (sc + 1.f) + sh; v2u o; o.x = pk2(y.x, y.y); o.y = pk2(y.z, y.w); ((GAS v2u*)dst)[lane + 64 * j] = o; }
}

DI void prologue1(Frame& F, CArgsP a) {
    unsigned char* const ws = WSP(F);
    const int gw = F.vcu * 8 + F.wave, NGW = F.G * 8;
    const float* MOD = (const float*)(ws + WS_MOD);
    for (int i = gw * 64 + F.lane; i < 4 * 5 * 1024; i += NGW * 64) { const int lm = i >> 10, k = i & 1023, l = lm / 5;
        ((float*)(ws + WS_AM))[i] = a->in[I_N2G][l * 1024 + k] * (1.f + MOD[(size_t)lm * 6144 + 4 * 1024 + k]); }
#pragma unroll 1
    for (int row = gw; row < NTOK; row += NGW) {
        const float* src = row < NLAT ? a->in[I_X] + (size_t)row * 1024 : a->in[I_CTX] + (size_t)(row - NLAT) * 1024;
        const float* m = MOD + (size_t)(0 * 5 + mod_row(row)) * 6144;
        norm_mod_row(src, (bf16*)(ws + WS_H) + (size_t)row * 1024, a->in[I_N1G], m, m + 1024, (bf16*)(ws + WS_XN) + (size_t)row * 1024, F.lane);
    }
}
struct PlainOrder {
    const char* A; const char* B; size_t atile, btile; int nM, nN, G, c, GN; const char* SC = nullptr; bool split = false;
    DI bool next(int i, pg8::Unit& u) const {
        int L = i * G + c; u.half = 0; u.roff = 0;
        { const int N = nM * nN, F = (N / G) * G, rem = N - F;
          if (split && rem > 0 && 2 * rem <= G && L >= F) { const int h = L - F; if (h >= 2 * rem) return false; L = F + (h >> 1); u.half = 1; u.roff = (h & 1) * 128; }
          else if (L >= N) return false; }
        const int full = nN / GN, per = nM * GN;
        if (L < full * per) { const int p = L / per, r = L - p * per; u.pm = r / GN; u.pn = p * GN + (r - u.pm * GN); }
        else { const int rem = nN - full * GN, r = L - full * per; u.pm = r / rem; u.pn = full * GN + (r - u.pm * rem); }
        u.g = 0; u.aux = 0; u.rowidx = nullptr; u.nvalid = 0; u.S = SC + (size_t)u.pn * 8192;
        u.A = A + (size_t)u.pm * atile + (size_t)u.roff * (atile >> 8); u.B = B + (size_t)u.pn * btile; return true;
    }
};
struct GroupOrder {
    const char* A; const char* B; size_t atile, btile, agroup, bgroup; int nM, nN, nG, G, c;
    DI bool next(int i, pg8::Unit& u) const {
        const long L = (long)i * G + c; const int per = nM * nN; if (L >= (long)per * nG) return false;
        u.g = (int)(L / per); const int r = (int)(L % per); u.pn = r / nM; u.pm = r % nM; u.aux = 0; u.rowidx = nullptr; u.nvalid = 0; u.S = nullptr; u.half = 0; u.roff = 0;
        u.A = A + (size_t)u.g * agroup + (size_t)u.pm * atile; u.B = B + (size_t)u.g * bgroup + (size_t)u.pn * btile; return true;
    }
};
struct MoeOrder {
    const char* A; const char* B; size_t bexp, btile; int nN, G, c; const LAS int* tab; const int* inv; bool gather; const char* SC; size_t sexp;
    DI bool next(int i, pg8::Unit& u) const {
        int L = i * G + c; int hf = 0, ro = 0;
        { const int N = tab[33 + 32], F = (N / G) * G, rem = N - F;
          if (rem > 0 && 2 * rem <= G && L >= F) { const int h = L - F; if (h >= 2 * rem) return false; L = F + (h >> 1); hf = 1; ro = (h & 1) * 128; }
          else if (L >= N) return false; }
        int e = 0;
#pragma unroll 1
        for (int k = 16; k >= 1; k >>= 1) if (tab[33 + e + k] <= L) e += k;
        const int r = L - tab[33 + e], mt = tab[66 + e], per = mt * 4, pnl = r / per, r2 = r - pnl * per;
        u.g = e; u.pm = r2 >> 2; u.pn = pnl * 4 + (r2 & 3); u.aux = tab[e] + u.pm * 256; u.half = hf; u.roff = ro;
        u.rowidx = inv + (size_t)e * NTOK + u.pm * 256; u.nvalid = tab[98 + e] - u.pm * 256;
        u.A = gather ? A : A + (size_t)(u.aux + ro) * 1024;
        u.B = B + (size_t)e * bexp + (size_t)u.pn * btile; u.S = SC + (size_t)e * sexp + (size_t)u.pn * 8192; return true;
    }
};

typedef f32x4 AccT[2][2][4][2];
DI v2u pkb4(f32x4 v) { v2u r; r.x = cvt_pk_bf16(v.x, v.y); r.y = cvt_pk_bf16(v.z, v.w); return r; }
template <class Fn> DI void epi_loop_perm(const AccT& acc, int wr, int wc, int fr, int fq, Fn fn, int half = 0, int roff = 0) {
#pragma unroll
    for (int ai = 0; ai < 2; ++ai) { if (ai == 1 && half) break;
#pragma unroll
        for (int m = 0; m < 4; ++m) { const int r = roff + ai * 128 + wr * 64 + m * 16 + fr;
#pragma unroll
            for (int bj = 0; bj < 2; ++bj) fn(r, bj * 128 + wc * 32 + 8 * fq, acc[ai][bj][m][0], acc[ai][bj][m][1]); } }
}
DI v4u pack8(const f32x4& a, const f32x4& b) { v4u w; w.x = cvt_pk_bf16(a.x, a.y); w.y = cvt_pk_bf16(a.z, a.w); w.z = cvt_pk_bf16(b.x, b.y); w.w = cvt_pk_bf16(b.z, b.w); return w; }

struct EpiUG { static constexpr bool PERM = true; static constexpr bool BIAS_INIT = false; static constexpr float BIAS1_ADD = 0.f; bf16* UG;
    DI void operator()(const AccT& acc, const pg8::Unit& u, int wr, int wc, int fr, int fq) const {
        epi_loop_perm(acc, wr, wc, fr, fq, [&](int r, int c0, const f32x4& v0, const f32x4& v1) { const int row = u.pm * 256 + r, col = u.pn * 256 + c0;
            *(GAS v4u*)(UG + ((size_t)(col >> 4) * S5ROWS + (row >> 5)) * S5K + (row & 31) * 16 + (col & 15)) = pack8(v0, v1); });
    } };
struct EpiPQt { static constexpr bool PERM = true; static constexpr bool BIAS_INIT = false; static constexpr float BIAS1_ADD = 0.f; bf16* O;
    DI void operator()(const AccT& acc, const pg8::Unit& u, int wr, int wc, int fr, int fq) const {
        epi_loop_perm(acc, wr, wc, fr, fq, [&](int r, int c0, const f32x4& v0, const f32x4& v1) { const int row = u.pm * 256 + r, col = u.pn * 256 + c0; *(GAS v4u*)(O + (size_t)row * NTOK + col) = pack8(v0, v1); }, u.half, u.roff);
    } };
struct EpiVT { static constexpr bool PERM = true; static constexpr bool BIAS_INIT = false; static constexpr float BIAS1_ADD = 0.f; bf16* VT;
    DI void operator()(const AccT& acc, const pg8::Unit& u, int wr, int wc, int fr, int fq) const {
        const int tok0 = u.pn * 256; int b, kp0; if (tok0 < NLAT) { b = tok0 >> 13; kp0 = CTXL + (tok0 & 8191); } else { b = (tok0 - NLAT) >> 8; kp0 = 0; }
        epi_loop_perm(acc, wr, wc, fr, fq, [&](int r, int c0, const f32x4& v0, const f32x4& v1) { const int row = u.pm * 256 + r; *(GAS v4u*)(VT + ((size_t)b * 512 + row) * KV_LEN + kp0 + c0) = pack8(v0, v1); }, u.half, u.roff);
    } };
struct EpiSloc { static constexpr bool PERM = false; static constexpr bool BIAS_INIT = false; static constexpr float BIAS1_ADD = 0.f; float* S;
    DI void operator()(const AccT& acc, const pg8::Unit& u, int wr, int wc, int fr, int fq) const {
#pragma unroll
        for (int ai = 0; ai < 2; ++ai)
#pragma unroll
            for (int m = 0; m < 4; ++m) { const int r = u.pm * 256 + ai * 128 + wr * 64 + m * 16 + fr; float* rp = S + ((size_t)u.g * S5ROWS + r) * 256 + wc * 32 + 4 * fq;
#pragma unroll
                for (int bj = 0; bj < 2; ++bj)
#pragma unroll
                    for (int n = 0; n < 2; ++n) *(GAS f32x4*)(rp + bj * 128 + n * 16) = acc[ai][bj][m][n]; }
    } };
struct EpiS5Out { static constexpr bool PERM = true; static constexpr bool BIAS_INIT = false; static constexpr float BIAS1_ADD = 0.f; bf16* YB;
    DI void operator()(const AccT& acc, const pg8::Unit& u, int wr, int wc, int fr, int fq) const {
        epi_loop_perm(acc, wr, wc, fr, fq, [&](int r, int c0, const f32x4& v0, const f32x4& v1) { const int row = u.pm * 256 + r, col = u.pn * 256 + c0;
            if (row < 1056) { f32x4 a, b;
#pragma unroll
                for (int i = 0; i < 4; ++i) { a[i] = gelu_tanh(v0[i]); b[i] = gelu_tanh(v1[i]); }
                *(GAS v4u*)(YB + ((size_t)row * 32 + (col >> 4)) * 768 + u.g * 16 + (col & 15)) = pack8(a, b); } });
    } };
struct EpiGLU { static constexpr bool PERM = true; static constexpr bool BIAS_INIT = true; static constexpr float BIAS1_ADD = 0.f; const bf16* YB; const bf16* bias; bf16* CAT;
    DI void load_bias(const pg8::Unit& u, int wc, int fq, v2u (&b)[2][2]) const { const bf16* bp = bias + u.pn * 256 + wc * 32 + 8 * fq;
#pragma unroll
        for (int bj = 0; bj < 2; ++bj) { b[bj][0] = *(const GAS v2u*)(bp + bj * 128); b[bj][1] = *(const GAS v2u*)(bp + bj * 128 + 4); } }
    DI void operator()(const AccT& acc, const pg8::Unit& u, int wr, int wc, int fr, int fq) const {
        epi_loop_perm(acc, wr, wc, fr, fq, [&](int r, int c0, const f32x4& v0, const f32x4& v1) { const int row = u.pm * 256 + r, col = u.pn * 256 + c0;
            const v4u yw = *(const GAS v4u*)(YB + (size_t)row * 768 + col);
            f32x4 a, b; const unsigned ys[4] = {yw.x, yw.y, yw.z, yw.w};
#pragma unroll
            for (int i = 0; i < 4; ++i) { const float y0 = (i & 1) ? bfhi(ys[i >> 1]) : bflo(ys[i >> 1]); const float y1 = (i & 1) ? bfhi(ys[2 + (i >> 1)]) : bflo(ys[2 + (i >> 1)]);
                a[i] = y0 * sigmoidf_(v0[i]); b[i] = y1 * sigmoidf_(v1[i]); }
            v2u o; o.x = pk4_fp8(a.x, a.y, a.z, a.w); o.y = pk4_fp8(b.x, b.y, b.z, b.w); *(GAS v2u*)((unsigned char*)CAT + (size_t)row * 1024 + 256 + col) = o; });
    } };
struct EpiResid { static constexpr bool PERM = true; static constexpr bool BIAS_INIT = false; static constexpr float BIAS1_ADD = 0.f; bf16* H; const float* gate;
    DI void operator()(const AccT& acc, const pg8::Unit& u, int wr, int wc, int fr, int fq) const {
        const float* gp = gate + (size_t)mod_row(u.pm * 256) * 6144 + u.pn * 256 + wc * 32 + 8 * fq;
        f32x4 gv[2][2];
#pragma unroll
        for (int bj = 0; bj < 2; ++bj) { gv[bj][0] = *(const GAS f32x4*)(gp + bj * 128); gv[bj][1] = *(const GAS f32x4*)(gp + bj * 128 + 4); }
#pragma unroll
        for (int ai = 0; ai < 2; ++ai) { if (ai == 1 && u.half) break;
#pragma unroll
            for (int m = 0; m < 4; ++m) { const int r = u.pm * 256 + u.roff + ai * 128 + wr * 64 + m * 16 + fr; bf16* rp = H + (size_t)r * 1024 + u.pn * 256 + wc * 32 + 8 * fq;
#pragma unroll
                for (int bj = 0; bj < 2; ++bj) { const v4u hw = *(const GAS v4u*)(rp + bj * 128);
                    const f32x4 h0 = {bflo(hw.x), bfhi(hw.x), bflo(hw.y), bfhi(hw.y)}, h1 = {bflo(hw.z), bfhi(hw.z), bflo(hw.w), bfhi(hw.w)};
                    *(GAS v4u*)(rp + bj * 128) = pack8(h0 + gv[bj][0] * acc[ai][bj][m][0], h1 + gv[bj][1] * acc[ai][bj][m][1]); } } }
    } };
struct EpiOddIn { static constexpr bool PERM = false; static constexpr bool BIAS_INIT = false; static constexpr float BIAS1_ADD = 0.f; bf16 *U, *VS, *Q, *KALL; const float* rope; float qscale;
    DI void operator()(const AccT& acc, const pg8::Unit& u, int wr, int wc, int fr, int fq) const {
        const int sect = u.pn >> 1;
        const int colbase = (u.pn & 1) * 256;
        const int row00 = u.pm * 256 + u.roff; const bool lat = row00 < NLAT;
#pragma unroll
        for (int ai = 0; ai < 2; ++ai) { if (ai == 1 && u.half) break;
#pragma unroll
            for (int m = 0; m < 4; ++m) { const int row = row00 + ai * 128 + wr * 64 + m * 16 + fr; asm volatile("" ::: "memory");
#pragma unroll
                for (int bj = 0; bj < 2; ++bj) { f32x4 x1 = acc[ai][bj][m][0], x2 = acc[ai][bj][m][1]; const int c = colbase + bj * 128 + wc * 32 + 4 * fq;
                    if (sect < 2) {
#pragma unroll
                        for (int i = 0; i < 4; ++i) { x1[i] = gelu_tanh(x1[i]); x2[i] = gelu_tanh(x2[i]); }
                        bf16* dst = (sect == 0 ? U : VS) + (size_t)row * 512 + c;
                        v2u o; o.x = cvt_pk_bf16(x1.x, x1.y); o.y = cvt_pk_bf16(x1.z, x1.w); *(GAS v2u*)dst = o; o.x = cvt_pk_bf16(x2.x, x2.y); o.y = cvt_pk_bf16(x2.z, x2.w); *(GAS v2u*)(dst + 16) = o;
                    } else {
                        if (lat) { const int t = row & 8191, pos = (wc & 1) ? (t & 63) : (t >> 6); const float* rp = rope + (size_t)(pos * 16 + 4 * fq) * 2;
                            const f32x4 cs0 = *(const GAS f32x4*)rp, cs1 = *(const GAS f32x4*)(rp + 4);
                            const float cc[4] = {cs0.x, cs0.z, cs1.x, cs1.z}, ss[4] = {cs0.y, cs0.w, cs1.y, cs1.w};
#pragma unroll
                            for (int i = 0; i < 4; ++i) { const float a = x1[i], b = x2[i]; x1[i] = a * cc[i] - b * ss[i]; x2[i] = b * cc[i] + a * ss[i]; } }
                        bf16* dst;
                        if (sect == 2) { x1 = x1 * qscale; x2 = x2 * qscale; dst = Q + (size_t)row * 512 + c; }
                        else { int kr; if (lat) kr = (row >> 13) * KV_LEN + CTXL + (row & 8191); else kr = ((row - NLAT) >> 8) * KV_LEN + ((row - NLAT) & 255); dst = KALL + (size_t)kr * 512 + c; }
                        v2u o; o.x = cvt_pk_bf16(x1.x, x1.y); o.y = cvt_pk_bf16(x1.z, x1.w); *(GAS v2u*)dst = o; o.x = cvt_pk_bf16(x2.x, x2.y); o.y = cvt_pk_bf16(x2.z, x2.w); *(GAS v2u*)(dst + 16) = o;
                    } } } }
    } };
struct EpiSwiglu { static constexpr bool PERM = true; static constexpr bool BIAS_INIT = true; static constexpr float BIAS1_ADD = 1.f; const bf16* b1; bf16* ACT;
    DI void load_bias(const pg8::Unit& u, int wc, int fq, v2u (&b)[2][2]) const { const bf16* bp = b1 + (size_t)u.g * 2048 + u.pn * 128 + wc * 32 + 8 * fq;
        b[0][0] = *(const GAS v2u*)bp; b[0][1] = *(const GAS v2u*)(bp + 4); b[1][0] = *(const GAS v2u*)(bp + 1024); b[1][1] = *(const GAS v2u*)(bp + 1028); }
    DI void operator()(const AccT& acc, const pg8::Unit& u, int wr, int wc, int fr, int fq) const {
        const int c0 = wc * 32 + 8 * fq;
#pragma unroll
        for (int ai = 0; ai < 2; ++ai) { if (ai == 1 && u.half) break;
#pragma unroll
            for (int m = 0; m < 4; ++m) { const int r = u.roff + ai * 128 + wr * 64 + m * 16 + fr; f32x4 o0, o1;
#pragma unroll
                for (int i = 0; i < 4; ++i) {
                    { const float gl = fminf(acc[ai][0][m][0][i], 7.f), l1 = fminf(fmaxf(acc[ai][1][m][0][i], -6.f), 8.f); o0[i] = (gl * l1) * fast_rcp(1.f + fast_exp2(gl * -2.4554669595930157f)); }
                    { const float gl = fminf(acc[ai][0][m][1][i], 7.f), l1 = fminf(fmaxf(acc[ai][1][m][1][i], -6.f), 8.f); o1[i] = (gl * l1) * fast_rcp(1.f + fast_exp2(gl * -2.4554669595930157f)); } }
                v2u o; o.x = pk4_fp8_nc(o0.x, o0.y, o0.z, o0.w); o.y = pk4_fp8_nc(o1.x, o1.y, o1.z, o1.w);
                *(GAS v2u*)((unsigned char*)ACT + (size_t)(u.aux + r) * 1024 + u.pn * 128 + c0) = o; } }
    } };
struct EpiMoe2 { static constexpr bool PERM = true; static constexpr bool BIAS_INIT = true; static constexpr float BIAS1_ADD = 0.f; const bf16* b2; bf16* YT;
    DI void load_bias(const pg8::Unit& u, int wc, int fq, v2u (&b)[2][2]) const { const bf16* bp = b2 + (size_t)u.g * 1024 + u.pn * 256 + wc * 32 + 8 * fq;
#pragma unroll
        for (int bj = 0; bj < 2; ++bj) { b[bj][0] = *(const GAS v2u*)(bp + bj * 128); b[bj][1] = *(const GAS v2u*)(bp + bj * 128 + 4); } }
    DI void operator()(const AccT& acc, const pg8::Unit& u, int wr, int wc, int fr, int fq) const {
        const int cb = u.pn * 256 + wc * 32 + 8 * fq;
#pragma unroll
        for (int ai = 0; ai < 2; ++ai) { if (ai == 1 && u.half) break;
#pragma unroll
            for (int m = 0; m < 4; ++m) { const int r = u.roff + ai * 128 + wr * 64 + m * 16 + fr;
                if (r < u.nvalid) { const int tk = ((const GAS int*)u.rowidx)[r]; unsigned char* rp = (unsigned char*)YT + (size_t)tk * 1024 + cb;
#pragma unroll
                    for (int bj = 0; bj < 2; ++bj) { const f32x4 y0 = acc[ai][bj][m][0], y1 = acc[ai][bj][m][1]; v2u o; o.x = pk4_fp8(y0.x, y0.y, y0.z, y0.w); o.y = pk4_fp8(y1.x, y1.y, y1.z, y1.w);
                        *(GAS v2u*)(rp + bj * 128) = o; } } } }
    } };
DI unsigned brev(unsigned x, int bits) { return __builtin_bitreverse32(x) >> (32 - bits); }
DI void fft8192_unit(Frame& F, const bf16* P, const bf16* Q, unsigned char* dst, float scale) {
    LAS f32x2* X = (LAS f32x2*)F.lds;
    const LAS f32x2* TW = (const LAS f32x2*)(F.lds + 65536);
    for (int i = F.tid; i < 1024; i += 512) { const v4u p = ((const GAS v4u*)P)[i], q = ((const GAS v4u*)Q)[i]; const unsigned pw[4] = {p.x, p.y, p.z, p.w}, qw[4] = {q.x, q.y, q.z, q.w};
#pragma unroll
        for (int e = 0; e < 4; ++e) { X[i * 8 + 2 * e] = (f32x2){bflo(pw[e]), -bflo(qw[e])}; X[i * 8 + 2 * e + 1] = (f32x2){bfhi(pw[e]), -bfhi(qw[e])}; } }
    __syncthreads();
#pragma unroll 1
    for (int h = 4096, sh = 0; h >= 2; h >>= 2, sh += 2) { const int h2 = h >> 1;
#pragma unroll
        for (int u = 0; u < 4; ++u) { const int q = F.tid + 512 * u, j = q & (h2 - 1), i = ((q - j) << 2) | j;
            const f32x2 x0 = X[i], x1 = X[i + h2], x2 = X[i + h], x3 = X[i + h + h2];
            const f32x2 wa = TW[j << sh], wb = TW[(j + h2) << sh], wc = TW[j << (sh + 1)];
            const f32x2 a0 = x0 + x2, d0 = x0 - x2, a1 = x1 + x3, d1 = x1 - x3;
            const f32x2 a2 = {d0.x * wa.x - d0.y * wa.y, d0.x * wa.y + d0.y * wa.x}, a3 = {d1.x * wb.x - d1.y * wb.y, d1.x * wb.y + d1.y * wb.x};
            const f32x2 e0 = a0 - a1, e1 = a2 - a3;
            X[i] = a0 + a1; X[i + h2] = (f32x2){e0.x * wc.x - e0.y * wc.y, e0.x * wc.y + e0.y * wc.x};
            X[i + h] = a2 + a3; X[i + h + h2] = (f32x2){e1.x * wc.x - e1.y * wc.y, e1.x * wc.y + e1.y * wc.x}; }
        __syncthreads();
    }
    {
#pragma unroll
        for (int u = 0; u < 8; ++u) { const int i = 2 * (F.tid + 512 * u); const f32x2 a = X[i], b = X[i + 1]; X[i] = a + b; X[i + 1] = a - b; }
        __syncthreads();
    }
    for (int i = F.tid; i < 8192; i += 512) dst[(size_t)brev(i, 13) * 1024] = f8_1(X[i].x * scale);
    __syncthreads();
}
DI void fft256x8_unit(Frame& F, const bf16* P, const bf16* Q, unsigned char* dst, float scale) {
    LAS f32x2* X = (LAS f32x2*)F.lds + F.wave * 256;
    const LAS f32x2* TW = (const LAS f32x2*)(F.lds + 65536);
#pragma unroll
    for (int u = 0; u < 4; ++u) { const int i = F.lane + 64 * u; X[i] = (f32x2){bf2f(P[i]), -bf2f(Q[i])}; }
    __syncthreads();
#pragma unroll 1
    for (int h = 128, sh = 5; h >= 2; h >>= 2, sh += 2) { const int h2 = h >> 1;
        { const int q = F.lane, j = q & (h2 - 1), i = ((q - j) << 2) | j;
            const f32x2 x0 = X[i], x1 = X[i + h2], x2 = X[i + h], x3 = X[i + h + h2];
            const f32x2 wa = TW[j << sh], wb = TW[(j + h2) << sh], wc = TW[(j << (sh + 1)) & 4095];
            const f32x2 a0 = x0 + x2, d0 = x0 - x2, a1 = x1 + x3, d1 = x1 - x3;
            const f32x2 a2 = {d0.x * wa.x - d0.y * wa.y, d0.x * wa.y + d0.y * wa.x}, a3 = {d1.x * wb.x - d1.y * wb.y, d1.x * wb.y + d1.y * wb.x};
            const f32x2 e0 = a0 - a1, e1 = a2 - a3;
            X[i] = a0 + a1; X[i + h2] = (f32x2){e0.x * wc.x - e0.y * wc.y, e0.x * wc.y + e0.y * wc.x};
            X[i + h] = a2 + a3; X[i + h + h2] = (f32x2){e1.x * wc.x - e1.y * wc.y, e1.x * wc.y + e1.y * wc.x}; }
        __syncthreads();
    }
#pragma unroll
    for (int u = 0; u < 4; ++u) { const int i = F.lane + 64 * u; dst[(size_t)brev(i, 8) * 1024] = f8_1(X[i].x * scale); }
    __syncthreads();
}
DI void fft_phase(Frame& F, bool rev_order) {
    unsigned char* const ws = WSP(F);
    { const GAS f32x2* tw = (const GAS f32x2*)(ws + WS_TW); LAS f32x2* T = (LAS f32x2*)(F.lds + 65536); for (int i = F.tid; i < 4096; i += 512) T[i] = tw[i]; }
    __syncthreads();
    const bf16* PQ = (const bf16*)(ws + WS_PQT); unsigned char* CAT = ws + WS_CAT;
    const int c = rev_order ? (F.G - 1 - F.vcu) : F.vcu;
    for (int it = c; it < 1024 + 128; it += F.G) {
        if (it < 1024) { const int b = it >> 8, col = it & 255;
            fft8192_unit(F, PQ + (size_t)col * NTOK + b * SEQ, PQ + (size_t)(256 + col) * NTOK + b * SEQ, CAT + (size_t)b * SEQ * 1024 + col, 1.f / 724.0773439350247f);
        } else { const int r = it - 1024, b = r >> 5, col = (r & 31) * 8 + F.wave;
            fft256x8_unit(F, PQ + (size_t)col * NTOK + NLAT + b * CTXL, PQ + (size_t)(256 + col) * NTOK + NLAT + b * CTXL, CAT + (size_t)(NLAT + b * CTXL) * 1024 + col, 1.f / 128.f); }
    }
}

DI void s5_carry_phase(Frame& F, int j) {
    unsigned char* const ws = WSP(F);
    const int gw = F.wave * F.G + F.vcu, NGW = F.G * 8;
    const float* SL = (const float*)(ws + WS_SLOC); bf16* UG = (bf16*)(ws + WS_UG);
    for (int it = gw; it < 4 * 48 * 2; it += NGW) {
        const int dir = it & 1, g = (it >> 1) % 48, b = it / 96;
        const f32x2 aT = ((const GAS f32x2*)(ws + WS_APT))[((size_t)(j * 2 + dir) * 48 + g) * 64 + F.lane];
        float hr = 0.f, hi = 0.f;
#define S5C_ROW(s) ((s) < 8 ? 1024 + b * 8 + (dir ? 7 - (s) : (s)) : b * 256 + (dir ? 255 - ((s) - 8) : ((s) - 8)))
#define S5C_LOAD(buf, s0_) do { _Pragma("unroll") for (int e = 0; e < 24; ++e) { const int r_ = S5C_ROW((s0_) + e); buf[e] = *(const GAS f32x2*)(SL + ((size_t)g * S5ROWS + r_) * 256 + dir * 128 + 2 * F.lane); } } while (0)
#define S5C_STEP(buf, s0_) do { _Pragma("unroll") for (int e = 0; e < 24; ++e) { const int r_ = S5C_ROW((s0_) + e); \
            *(GAS unsigned*)(UG + ((size_t)g * S5ROWS + r_) * S5K + 512 + dir * 128 + 2 * F.lane) = pk2(hr, hi); \
            const float nr = aT.x * hr - aT.y * hi + buf[e].x, ni = aT.x * hi + aT.y * hr + buf[e].y; hr = nr; hi = ni; } } while (0)
        f32x2 svA[24], svB[24];
        S5C_LOAD(svA, 0);
#pragma unroll 1
        for (int s0 = 0; s0 < 264; s0 += 48) {
            const bool second = s0 + 24 < 264;
            if (second) S5C_LOAD(svB, s0 + 24);
            S5C_STEP(svA, s0);
            if (second) { if (s0 + 48 < 264) S5C_LOAD(svA, s0 + 48); S5C_STEP(svB, s0 + 24); }
        }
#undef S5C_ROW
#undef S5C_LOAD
#undef S5C_STEP
    }
}

DI void sgu_unit(Frame& F, CArgsP a, int j, int cr, int g) {
    unsigned char* const ws = WSP(F);
    LAS bf16* VN = (LAS bf16*)F.lds;
    const int row0 = cr * 128;
    const bf16* VS = (const bf16*)(ws + WS_VS); const bf16* U = (const bf16*)(ws + WS_U); unsigned char* CAT = ws + WS_CAT;
    {
        const int p = F.tid >> 2, part = F.tid & 3; float x[32];
        const GAS v4u* src = (const GAS v4u*)(VS + (size_t)(row0 + p) * 512 + g * 128 + part * 32);
#pragma unroll
        for (int q = 0; q < 4; ++q) { const v4u w = src[q]; const unsigned ww[4] = {w.x, w.y, w.z, w.w};
#pragma unroll
            for (int e = 0; e < 4; ++e) { x[q * 8 + 2 * e] = bflo(ww[e]); x[q * 8 + 2 * e + 1] = bfhi(ww[e]); } }
        float s = 0.f;
#pragma unroll
        for (int i = 0; i < 32; ++i) s += x[i];
        s += __shfl_xor(s, 1); s += __shfl_xor(s, 2);
        const float mu = s * (1.f / 128.f); float v = 0.f;
#pragma unroll
        for (int i = 0; i < 32; ++i) { x[i] -= mu; v += x[i] * x[i]; }
        v += __shfl_xor(v, 1); v += __shfl_xor(v, 2);
        const float rstd = 1.f / sqrtf(v * (1.f / 128.f) + EPS);
        const float* lg = a->in[I_SGULNG] + (size_t)(j * 4 + g) * 128 + part * 32; const float* lb = a->in[I_SGULNB] + (size_t)(j * 4 + g) * 128 + part * 32;
#pragma unroll
        for (int i = 0; i < 32; ++i) VN[(part * 32 + i) * 136 + p] = (bf16)f2bf(x[i] * rstd * lg[i] + lb[i]);
    }
    __syncthreads();
    const int r = F.lane & 31, h = F.lane >> 5, qb = F.wave >> 1, ch = F.wave & 1;
    const bf16* Wg = (const bf16*)(ws + WS_SGUW) + (size_t)(j * 4 + g) * 16384 + (size_t)(qb * 32 + r) * 128;
    f32x16 acc[2];
#pragma unroll
    for (int i = 0; i < 16; ++i) { acc[0][i] = 0.f; acc[1][i] = 0.f; }
#pragma unroll
    for (int ks = 0; ks < 8; ++ks) { const bf16x8 af = *(const GAS bf16x8*)(Wg + ks * 16 + 8 * h);
#pragma unroll
        for (int ct = 0; ct < 2; ++ct) { const bf16x8 bfm = *(const LAS bf16x8*)(VN + (ch * 64 + ct * 32 + r) * 136 + ks * 16 + 8 * h);
            acc[ct] = __builtin_amdgcn_mfma_f32_32x32x16_bf16(bfm, af, acc[ct], 0, 0, 0); } }
    const int q = qb * 32 + r; const float bq = a->in[I_SGUB][(size_t)(j * 4 + g) * 128 + q];
    const bf16* up = U + (size_t)(row0 + q) * 512 + g * 128 + ch * 64 + 4 * h; unsigned char* cp = CAT + (size_t)(row0 + q) * 1024 + g * 128 + ch * 64 + 4 * h;
#pragma unroll
    for (int ct = 0; ct < 2; ++ct)
#pragma unroll
        for (int q4 = 0; q4 < 4; ++q4) { const int co = ct * 32 + 8 * q4; const v2u uw = *(const GAS v2u*)(up + co);
            *(GAS unsigned*)(cp + co) = pk4_fp8(bflo(uw.x) * (acc[ct][4 * q4] + bq), bfhi(uw.x) * (acc[ct][4 * q4 + 1] + bq), bflo(uw.y) * (acc[ct][4 * q4 + 2] + bq), bfhi(uw.y) * (acc[ct][4 * q4 + 3] + bq)); }
    __syncthreads();
}

DI bf16x8 pack_step(const f32x16& x, int s) {
    v4u p; p.x = cvt_pk_bf16(x[8 * s], x[8 * s + 1]); p.y = cvt_pk_bf16(x[8 * s + 2], x[8 * s + 3]); p.z = cvt_pk_bf16(x[8 * s + 4], x[8 * s + 5]); p.w = cvt_pk_bf16(x[8 * s + 6], x[8 * s + 7]);
    return __builtin_bit_cast(bf16x8, p);
}
constexpr int AT_KROW = 144, AT_VROW = 272;
constexpr int AT_KBYTES = 128 * AT_KROW, AT_VBYTES = 128 * AT_VROW, AT_STAGE = AT_KBYTES + AT_VBYTES;
constexpr float AT_THR = 12.f;
DI float max3f(float a, float b, float c) { return fmaxf(fmaxf(a, b), c); }
DI void attn_pass(Frame& F, const bf16* Qrow, const bf16* Kb, const bf16* Vb, int nkt, int rot, f32x16 (&O)[4], float& lsum) {
    const int r = F.lane & 31, h = F.lane >> 5;
    bf16x8 qf[4];
#pragma unroll
    for (int ds = 0; ds < 4; ++ds) qf[ds] = *(const GAS bf16x8*)(Qrow + ds * 16 + 8 * h);
    const f32x16 ZERO16 = {0.f, 0.f, 0.f, 0.f, 0.f, 0.f, 0.f, 0.f, 0.f, 0.f, 0.f, 0.f, 0.f, 0.f, 0.f, 0.f};
#pragma unroll
    for (int d = 0; d < 4; ++d) O[d] = ZERO16;
    float mref = 0.f;
#pragma unroll
    for (int ds = 0; ds < 4; ++ds) { const bf16x8 kv = *(const GAS bf16x8*)(Kb + ds * 16 + 8 * h);
#pragma unroll
        for (int e = 0; e < 8; ++e) mref += bf2f((unsigned short)qf[ds][e]) * bf2f((unsigned short)kv[e]); }
    mref += __shfl_xor(mref, 32);
    lsum = 0.f;
    const unsigned kgo = (unsigned)((F.tid >> 3) * 1024 + (F.tid & 7) * 16), vgo = (unsigned)((F.tid >> 4) * (KV_LEN * 2) + (F.tid & 15) * 16);
    const int kl = (F.tid >> 3) * AT_KROW + (F.tid & 7) * 16, vl = AT_KBYTES + (F.tid >> 4) * AT_VROW + ((F.tid & 15) >> 1) * 32 + (F.tid & 1) * 8;
    const char* kbase = (const char*)Kb; const char* vbase = (const char*)Vb;
#define AT_LOADK(i, t) (*(const GAS v4u*)(kbase + (size_t)(t) * (128 * 1024) + (size_t)(i) * (64 * 1024) + kgo))
#define AT_LOADV(i, t) (*(const GAS v4u*)(vbase + (size_t)(t) * 256 + (size_t)(i) * (32 * KV_LEN * 2) + vgo))
#define AT_STORE(stp) do { _Pragma("unroll") for (int i_ = 0; i_ < 2; ++i_) *(LAS v4u*)((stp) + kl + i_ * (64 * AT_KROW)) = kr[i_]; \
        _Pragma("unroll") for (int i_ = 0; i_ < 4; ++i_) { *(LAS v2u*)((stp) + vl + i_ * (32 * AT_VROW)) = (v2u){vr[i_].x, vr[i_].y}; *(LAS v2u*)((stp) + vl + i_ * (32 * AT_VROW) + 16) = (v2u){vr[i_].z, vr[i_].w}; } } while (0)
    v4u kr[2], vr[4];
#pragma unroll
    for (int i = 0; i < 2; ++i) kr[i] = AT_LOADK(i, rot);
#pragma unroll
    for (int i = 0; i < 4; ++i) vr[i] = AT_LOADV(i, rot);
    AT_STORE(F.lds);
    __syncthreads();
    const unsigned lbase = (unsigned)(size_t)F.lds;
    const unsigned ka0 = lbase + r * AT_KROW + h * 16, va00 = lbase + AT_KBYTES + r * AT_VROW + 16 * h;
    bf16x8 kf[4], vf[4];
    f32x16 XA, XB;
#pragma unroll 1
    for (int kt = 0; kt < nkt; ++kt) {
        const unsigned so = (unsigned)((kt & 1) * AT_STAGE);
        const unsigned ka = ka0 + so, va0 = va00 + so, va1 = va0 + 32 * AT_VROW, va2 = va0 + 64 * AT_VROW, va3 = va0 + 96 * AT_VROW;
        asm volatile("ds_read_b128 %0, %4 offset:0\n\tds_read_b128 %1, %4 offset:32\n\tds_read_b128 %2, %4 offset:64\n\tds_read_b128 %3, %4 offset:96" : "=&v"(kf[0]), "=&v"(kf[1]), "=&v"(kf[2]), "=&v"(kf[3]) : "v"(ka) : "memory");
        if (kt + 1 < nkt) { int tn = kt + 1 + rot; tn = tn >= nkt ? tn - nkt : tn;
#pragma unroll
            for (int i = 0; i < 2; ++i) kr[i] = AT_LOADK(i, tn);
#pragma unroll
            for (int i = 0; i < 4; ++i) vr[i] = AT_LOADV(i, tn); }
        asm volatile("s_waitcnt lgkmcnt(0)" : "+v"(kf[0]), "+v"(kf[1]), "+v"(kf[2]), "+v"(kf[3]) :: "memory");
        XA = __builtin_amdgcn_mfma_f32_32x32x16_bf16(kf[0], qf[0], ZERO16, 0, 0, 0);
            XA = __builtin_amdgcn_mfma_f32_32x32x16_bf16(kf[1], qf[1], XA, 0, 0, 0);
            XA = __builtin_amdgcn_mfma_f32_32x32x16_bf16(kf[2], qf[2], XA, 0, 0, 0);
            XA = __builtin_amdgcn_mfma_f32_32x32x16_bf16(kf[3], qf[3], XA, 0, 0, 0);
        asm volatile("ds_read_b128 %0, %4 offset:4608\n\tds_read_b128 %1, %4 offset:4640\n\tds_read_b128 %2, %4 offset:4672\n\tds_read_b128 %3, %4 offset:4704" : "=&v"(kf[0]), "=&v"(kf[1]), "=&v"(kf[2]), "=&v"(kf[3]) : "v"(ka) : "memory");
        asm volatile("ds_read_b128 %0, %4 offset:0\n\tds_read_b128 %1, %5 offset:0\n\tds_read_b128 %2, %6 offset:0\n\tds_read_b128 %3, %7 offset:0" : "=&v"(vf[0]), "=&v"(vf[1]), "=&v"(vf[2]), "=&v"(vf[3]) : "v"(va0), "v"(va1), "v"(va2), "v"(va3) : "memory");

        {
            asm volatile("s_waitcnt lgkmcnt(0)" : "+v"(kf[0]), "+v"(kf[1]), "+v"(kf[2]), "+v"(kf[3]), "+v"(vf[0]), "+v"(vf[1]), "+v"(vf[2]), "+v"(vf[3]) :: "memory");
            XB = __builtin_amdgcn_mfma_f32_32x32x16_bf16(kf[0], qf[0], ZERO16, 0, 0, 0);
            XB = __builtin_amdgcn_mfma_f32_32x32x16_bf16(kf[1], qf[1], XB, 0, 0, 0);
            XB = __builtin_amdgcn_mfma_f32_32x32x16_bf16(kf[2], qf[2], XB, 0, 0, 0);
            XB = __builtin_amdgcn_mfma_f32_32x32x16_bf16(kf[3], qf[3], XB, 0, 0, 0);
            float mx = max3f(XA[0], XA[1], XA[2]);
#pragma unroll
            for (int i = 3; i < 15; i += 2) mx = max3f(mx, XA[i], XA[i + 1]);
            mx = fmaxf(mx, XA[15]) - mref;
            if (__builtin_amdgcn_ballot_w64(mx > AT_THR) != 0ull) {
                const float mo = fmaxf(mx, __shfl_xor(mx, 32)); const float delta = mo > AT_THR ? mo : 0.f, alpha = fast_exp2(-delta);
                mref += delta; lsum *= alpha;
#pragma unroll
                for (int d = 0; d < 4; ++d)
#pragma unroll
                    for (int i = 0; i < 16; ++i) O[d][i] *= alpha;
            }
            float ps0 = 0.f, ps1 = 0.f;
#pragma unroll
            for (int i = 0; i < 16; i += 2) { const float p0 = fast_exp2(XA[i] - mref), p1 = fast_exp2(XA[i + 1] - mref); XA[i] = p0; XA[i + 1] = p1; ps0 += p0; ps1 += p1; }
            lsum += ps0 + ps1;
            const bf16x8 pb0 = pack_step(XA, 0), pb1 = pack_step(XA, 1);
#pragma unroll
            for (int d = 0; d < 4; ++d) O[d] = __builtin_amdgcn_mfma_f32_32x32x16_bf16(vf[d], pb0, O[d], 0, 0, 0);
            asm volatile("ds_read_b128 %0, %4 offset:32\n\tds_read_b128 %1, %5 offset:32\n\tds_read_b128 %2, %6 offset:32\n\tds_read_b128 %3, %7 offset:32" : "=&v"(vf[0]), "=&v"(vf[1]), "=&v"(vf[2]), "=&v"(vf[3]) : "v"(va0), "v"(va1), "v"(va2), "v"(va3) : "memory");
            asm volatile("ds_read_b128 %0, %4 offset:9216\n\tds_read_b128 %1, %4 offset:9248\n\tds_read_b128 %2, %4 offset:9280\n\tds_read_b128 %3, %4 offset:9312" : "=&v"(kf[0]), "=&v"(kf[1]), "=&v"(kf[2]), "=&v"(kf[3]) : "v"(ka) : "memory");
            asm volatile("s_waitcnt lgkmcnt(0)" : "+v"(kf[0]), "+v"(kf[1]), "+v"(kf[2]), "+v"(kf[3]), "+v"(vf[0]), "+v"(vf[1]), "+v"(vf[2]), "+v"(vf[3]) :: "memory");
#pragma unroll
            for (int d = 0; d < 4; ++d) O[d] = __builtin_amdgcn_mfma_f32_32x32x16_bf16(vf[d], pb1, O[d], 0, 0, 0);
            asm volatile("ds_read_b128 %0, %4 offset:64\n\tds_read_b128 %1, %5 offset:64\n\tds_read_b128 %2, %6 offset:64\n\tds_read_b128 %3, %7 offset:64" : "=&v"(vf[0]), "=&v"(vf[1]), "=&v"(vf[2]), "=&v"(vf[3]) : "v"(va0), "v"(va1), "v"(va2), "v"(va3) : "memory");
        }
        {
            asm volatile("s_waitcnt lgkmcnt(0)" : "+v"(kf[0]), "+v"(kf[1]), "+v"(kf[2]), "+v"(kf[3]), "+v"(vf[0]), "+v"(vf[1]), "+v"(vf[2]), "+v"(vf[3]) :: "memory");
            XA = __builtin_amdgcn_mfma_f32_32x32x16_bf16(kf[0], qf[0], ZERO16, 0, 0, 0);
            XA = __builtin_amdgcn_mfma_f32_32x32x16_bf16(kf[1], qf[1], XA, 0, 0, 0);
            XA = __builtin_amdgcn_mfma_f32_32x32x16_bf16(kf[2], qf[2], XA, 0, 0, 0);
            XA = __builtin_amdgcn_mfma_f32_32x32x16_bf16(kf[3], qf[3], XA, 0, 0, 0);
            float mx = max3f(XB[0], XB[1], XB[2]);
#pragma unroll
            for (int i = 3; i < 15; i += 2) mx = max3f(mx, XB[i], XB[i + 1]);
            mx = fmaxf(mx, XB[15]) - mref;
            if (__builtin_amdgcn_ballot_w64(mx > AT_THR) != 0ull) {
                const float mo = fmaxf(mx, __shfl_xor(mx, 32)); const float delta = mo > AT_THR ? mo : 0.f, alpha = fast_exp2(-delta);
                mref += delta; lsum *= alpha;
#pragma unroll
                for (int d = 0; d < 4; ++d)
#pragma unroll
                    for (int i = 0; i < 16; ++i) O[d][i] *= alpha;
            }
            float ps0 = 0.f, ps1 = 0.f;
#pragma unroll
            for (int i = 0; i < 16; i += 2) { const float p0 = fast_exp2(XB[i] - mref), p1 = fast_exp2(XB[i + 1] - mref); XB[i] = p0; XB[i + 1] = p1; ps0 += p0; ps1 += p1; }
            lsum += ps0 + ps1;
            const bf16x8 pb0 = pack_step(XB, 0), pb1 = pack_step(XB, 1);
#pragma unroll
            for (int d = 0; d < 4; ++d) O[d] = __builtin_amdgcn_mfma_f32_32x32x16_bf16(vf[d], pb0, O[d], 0, 0, 0);
            asm volatile("ds_read_b128 %0, %4 offset:96\n\tds_read_b128 %1, %5 offset:96\n\tds_read_b128 %2, %6 offset:96\n\tds_read_b128 %3, %7 offset:96" : "=&v"(vf[0]), "=&v"(vf[1]), "=&v"(vf[2]), "=&v"(vf[3]) : "v"(va0), "v"(va1), "v"(va2), "v"(va3) : "memory");
            asm volatile("ds_read_b128 %0, %4 offset:13824\n\tds_read_b128 %1, %4 offset:13856\n\tds_read_b128 %2, %4 offset:13888\n\tds_read_b128 %3, %4 offset:13920" : "=&v"(kf[0]), "=&v"(kf[1]), "=&v"(kf[2]), "=&v"(kf[3]) : "v"(ka) : "memory");
            asm volatile("s_waitcnt lgkmcnt(0)" : "+v"(kf[0]), "+v"(kf[1]), "+v"(kf[2]), "+v"(kf[3]), "+v"(vf[0]), "+v"(vf[1]), "+v"(vf[2]), "+v"(vf[3]) :: "memory");
#pragma unroll
            for (int d = 0; d < 4; ++d) O[d] = __builtin_amdgcn_mfma_f32_32x32x16_bf16(vf[d], pb1, O[d], 0, 0, 0);
            asm volatile("ds_read_b128 %0, %4 offset:128\n\tds_read_b128 %1, %5 offset:128\n\tds_read_b128 %2, %6 offset:128\n\tds_read_b128 %3, %7 offset:128" : "=&v"(vf[0]), "=&v"(vf[1]), "=&v"(vf[2]), "=&v"(vf[3]) : "v"(va0), "v"(va1), "v"(va2), "v"(va3) : "memory");
        }
        {
            asm volatile("s_waitcnt lgkmcnt(0)" : "+v"(kf[0]), "+v"(kf[1]), "+v"(kf[2]), "+v"(kf[3]), "+v"(vf[0]), "+v"(vf[1]), "+v"(vf[2]), "+v"(vf[3]) :: "memory");
            XB = __builtin_amdgcn_mfma_f32_32x32x16_bf16(kf[0], qf[0], ZERO16, 0, 0, 0);
            XB = __builtin_amdgcn_mfma_f32_32x32x16_bf16(kf[1], qf[1], XB, 0, 0, 0);
            XB = __builtin_amdgcn_mfma_f32_32x32x16_bf16(kf[2], qf[2], XB, 0, 0, 0);
            XB = __builtin_amdgcn_mfma_f32_32x32x16_bf16(kf[3], qf[3], XB, 0, 0, 0);
            float mx = max3f(XA[0], XA[1], XA[2]);
#pragma unroll
            for (int i = 3; i < 15; i += 2) mx = max3f(mx, XA[i], XA[i + 1]);
            mx = fmaxf(mx, XA[15]) - mref;
            if (__builtin_amdgcn_ballot_w64(mx > AT_THR) != 0ull) {
                const float mo = fmaxf(mx, __shfl_xor(mx, 32)); const float delta = mo > AT_THR ? mo : 0.f, alpha = fast_exp2(-delta);
                mref += delta; lsum *= alpha;
#pragma unroll
                for (int d = 0; d < 4; ++d)
#pragma unroll
                    for (int i = 0; i < 16; ++i) O[d][i] *= alpha;
            }
            float ps0 = 0.f, ps1 = 0.f;
#pragma unroll
            for (int i = 0; i < 16; i += 2) { const float p0 = fast_exp2(XA[i] - mref), p1 = fast_exp2(XA[i + 1] - mref); XA[i] = p0; XA[i + 1] = p1; ps0 += p0; ps1 += p1; }
            lsum += ps0 + ps1;
            const bf16x8 pb0 = pack_step(XA, 0), pb1 = pack_step(XA, 1);
#pragma unroll
            for (int d = 0; d < 4; ++d) O[d] = __builtin_amdgcn_mfma_f32_32x32x16_bf16(vf[d], pb0, O[d], 0, 0, 0);
            asm volatile("ds_read_b128 %0, %4 offset:160\n\tds_read_b128 %1, %5 offset:160\n\tds_read_b128 %2, %6 offset:160\n\tds_read_b128 %3, %7 offset:160" : "=&v"(vf[0]), "=&v"(vf[1]), "=&v"(vf[2]), "=&v"(vf[3]) : "v"(va0), "v"(va1), "v"(va2), "v"(va3) : "memory");

            asm volatile("s_waitcnt lgkmcnt(0)" : "+v"(kf[0]), "+v"(kf[1]), "+v"(kf[2]), "+v"(kf[3]), "+v"(vf[0]), "+v"(vf[1]), "+v"(vf[2]), "+v"(vf[3]) :: "memory");
#pragma unroll
            for (int d = 0; d < 4; ++d) O[d] = __builtin_amdgcn_mfma_f32_32x32x16_bf16(vf[d], pb1, O[d], 0, 0, 0);
            asm volatile("ds_read_b128 %0, %4 offset:192\n\tds_read_b128 %1, %5 offset:192\n\tds_read_b128 %2, %6 offset:192\n\tds_read_b128 %3, %7 offset:192" : "=&v"(vf[0]), "=&v"(vf[1]), "=&v"(vf[2]), "=&v"(vf[3]) : "v"(va0), "v"(va1), "v"(va2), "v"(va3) : "memory");
        }
        {
            asm volatile("s_waitcnt lgkmcnt(0)" : "+v"(kf[0]), "+v"(kf[1]), "+v"(kf[2]), "+v"(kf[3]), "+v"(vf[0]), "+v"(vf[1]), "+v"(vf[2]), "+v"(vf[3]) :: "memory");
            float mx = max3f(XB[0], XB[1], XB[2]);
#pragma unroll
            for (int i = 3; i < 15; i += 2) mx = max3f(mx, XB[i], XB[i + 1]);
            mx = fmaxf(mx, XB[15]) - mref;
            if (__builtin_amdgcn_ballot_w64(mx > AT_THR) != 0ull) {
                const float mo = fmaxf(mx, __shfl_xor(mx, 32)); const float delta = mo > AT_THR ? mo : 0.f, alpha = fast_exp2(-delta);
                mref += delta; lsum *= alpha;
#pragma unroll
                for (int d = 0; d < 4; ++d)
#pragma unroll
                    for (int i = 0; i < 16; ++i) O[d][i] *= alpha;
            }
            float ps0 = 0.f, ps1 = 0.f;
#pragma unroll
            for (int i = 0; i < 16; i += 2) { const float p0 = fast_exp2(XB[i] - mref), p1 = fast_exp2(XB[i + 1] - mref); XB[i] = p0; XB[i + 1] = p1; ps0 += p0; ps1 += p1; }
            lsum += ps0 + ps1;
            const bf16x8 pb0 = pack_step(XB, 0), pb1 = pack_step(XB, 1);
#pragma unroll
            for (int d = 0; d < 4; ++d) O[d] = __builtin_amdgcn_mfma_f32_32x32x16_bf16(vf[d], pb0, O[d], 0, 0, 0);
            asm volatile("ds_read_b128 %0, %4 offset:224\n\tds_read_b128 %1, %5 offset:224\n\tds_read_b128 %2, %6 offset:224\n\tds_read_b128 %3, %7 offset:224" : "=&v"(vf[0]), "=&v"(vf[1]), "=&v"(vf[2]), "=&v"(vf[3]) : "v"(va0), "v"(va1), "v"(va2), "v"(va3) : "memory");

            asm volatile("s_waitcnt lgkmcnt(0)" : "+v"(kf[0]), "+v"(kf[1]), "+v"(kf[2]), "+v"(kf[3]), "+v"(vf[0]), "+v"(vf[1]), "+v"(vf[2]), "+v"(vf[3]) :: "memory");
#pragma unroll
            for (int d = 0; d < 4; ++d) O[d] = __builtin_amdgcn_mfma_f32_32x32x16_bf16(vf[d], pb1, O[d], 0, 0, 0);

        }
        if (kt + 1 < nkt) { LAS unsigned char* sn = F.lds + ((kt + 1) & 1) * AT_STAGE; AT_STORE(sn); }
        __syncthreads();
    }
    lsum += __shfl_xor(lsum, 32);
#undef AT_LOADK
#undef AT_LOADV
#undef AT_STORE
}

DI void attn_unit(Frame& F, CArgsP a, int jl, int layer, int qrow0, int b, int hd, int nkeys) {
    unsigned char* const ws = WSP(F);
    const int r = F.lane & 31, h = F.lane >> 5;
    const int qrow = qrow0 + F.wave * 32 + r;
    const bf16* Qp = (const bf16*)(ws + WS_Q) + (size_t)qrow * 512 + hd * 128;
    const bf16* Kp = (const bf16*)(ws + WS_KALL) + (size_t)b * KV_LEN * 512 + hd * 128;
    const bf16* Vp = (const bf16*)(ws + WS_VT) + ((size_t)b * 512 + hd * 128) * KV_LEN;
    const float lam = ((const float*)(ws + WS_CB))[jl * 2], lam_init = ((const float*)(ws + WS_CB))[jl * 2 + 1];
    f32x16 O[4]; float l1, l2;
    unsigned char* dst = ws + WS_CAT + (size_t)qrow * 1024 + 512 + hd * 128;
    bf16* park = (bf16*)(ws + WS_CAT + (size_t)NTOK * 1024) + (size_t)qrow * 512 + hd * 128;
    const int nkt = nkeys / 128, rot = (nkt >= 64) ? (int)(((F.vcu >> 3) & 31) * 2) : 0;
    attn_pass(F, Qp, Kp, Vp, nkt, rot, O, l1);
    { const float inv = 1.f / l1;
#pragma unroll
      for (int d = 0; d < 4; ++d)
#pragma unroll
          for (int q4 = 0; q4 < 4; ++q4) { const int dv = d * 32 + 8 * q4 + 4 * h;
              v2u o; o.x = cvt_pk_bf16(O[d][4 * q4] * inv, O[d][4 * q4 + 1] * inv); o.y = cvt_pk_bf16(O[d][4 * q4 + 2] * inv, O[d][4 * q4 + 3] * inv);
              *(GAS v2u*)(park + dv) = o; } }
    attn_pass(F, Qp + 64, Kp + 64, Vp, nkt, rot, O, l2);
    { const float inv = lam / l2; float ss = 0.f;
#pragma unroll
      for (int d = 0; d < 4; ++d)
#pragma unroll
          for (int q4 = 0; q4 < 4; ++q4) { const int dv = d * 32 + 8 * q4 + 4 * h; const v2u w = *(const GAS v2u*)(park + dv);
              const float x0 = bflo(w.x) - O[d][4 * q4] * inv, x1 = bfhi(w.x) - O[d][4 * q4 + 1] * inv, x2 = bflo(w.y) - O[d][4 * q4 + 2] * inv, x3 = bfhi(w.y) - O[d][4 * q4 + 3] * inv;
              O[d][4 * q4] = x0; O[d][4 * q4 + 1] = x1; O[d][4 * q4 + 2] = x2; O[d][4 * q4 + 3] = x3; ss += (x0 * x0 + x1 * x1) + (x2 * x2 + x3 * x3); }
      ss += __shfl_xor(ss, 32);
      const float sc = (1.f / sqrtf(ss * (1.f / 128.f) + EPS)) * (1.f - lam_init);
      const float* sg = a->in[I_SUBLN] + jl * 128;
#pragma unroll
      for (int d = 0; d < 4; ++d)
#pragma unroll
          for (int q4 = 0; q4 < 4; ++q4) { const int dv = d * 32 + 8 * q4 + 4 * h; const f32x4 g = *(const GAS f32x4*)(sg + dv);
              *(GAS unsigned*)(dst + dv) = pk4_fp8(O[d][4 * q4] * sc * g.x, O[d][4 * q4 + 1] * sc * g.y, O[d][4 * q4 + 2] * sc * g.z, O[d][4 * q4 + 3] * sc * g.w); } }
}
DI void moe_tables(Frame& F, int layer, int nN) {
    LAS int* tab = (LAS int*)(F.lds + TAB_OFF);
    __syncthreads();
    if (F.wave == 0) {
        const int e = F.lane & 31;
        const int c = (int)__hip_atomic_load(F.ctl + CW_CNT + layer * 32 + e, RLX_AGENT), mt = (c + 255) >> 8;
        int incl = mt;
#pragma unroll
        for (int o = 1; o < 32; o <<= 1) { const int t = __shfl_up(incl, o, 32); if (e >= o) incl += t; }
        const int excl = incl - mt;
        if (F.lane < 32) { tab[e] = excl * 256; tab[33 + e] = excl * nN; tab[66 + e] = mt; tab[98 + e] = c;
            if (e == 31) { tab[32] = incl * 256; tab[65] = incl * nN; } }
    }
    __syncthreads();
}

DI float rt_key(float logit, int e) { unsigned kb = __builtin_bit_cast(unsigned, logit); kb = (kb & 0xFFFFFFE0u) | ((kb >> 31) ? (unsigned)e : (unsigned)(31 - e)); return __builtin_bit_cast(float, kb); }
DI void router_phase(Frame& F, CArgsP a, int layer, int cnt_slot) {
    unsigned char* const ws = WSP(F);
    LAS unsigned char* rwh = F.lds;
    LAS unsigned char* rwl = F.lds + 32 * RT_PITCH;
    LAS int* hist = (LAS int*)(F.lds + 64 * RT_PITCH);
    LAS int* base = hist + 32;
    LAS int* rec_e = base + 32;
    LAS int* rec_r = rec_e + 1024;
    LAS float* rec_g = (LAS float*)(rec_r + 1024);
    const float* RW = a->in[I_RW] + (size_t)layer * 1024 * 32; const float* RB = a->in[I_RB] + layer * 32;
    { const GAS v4u* img = (const GAS v4u*)(ws + WS_RIMG + (size_t)layer * (64 * RT_PITCH));
      for (int i = F.tid; i < 64 * RT_PITCH / 16; i += 512) ((LAS v4u*)F.lds)[i] = img[i]; }
    if (F.tid < 32) hist[F.tid] = 0;
    __syncthreads();
    const int nrows_all = (layer == 3) ? NLAT : NTOK, ntask = nrows_all >> 4;
    const bf16* H = (const bf16*)(ws + WS_H); bf16* XN = (bf16*)(ws + WS_XN);
    const int l = F.lane, tkn = l & 15, kg = l >> 4;
    const unsigned fa0 = (unsigned)(size_t)rwh + tkn * RT_PITCH + kg * 16, fa1 = fa0 + 16 * RT_PITCH, fl0 = fa0 + 32 * RT_PITCH, fl1 = fa1 + 32 * RT_PITCH;
#pragma unroll 1
    for (int slot = 0; slot < 2; ++slot) {
        int task;
        if (slot == 0) task = (int)blockIdx.x * 8 + F.wave; else { if (F.wave != 0 || (blockIdx.x & 3) != 0) break; task = 2048 + (int)(blockIdx.x >> 2); }
        if (task >= ntask) break;
        const int row0 = task * 16, mr = mod_row(row0);
        const bf16* hp = H + (size_t)(row0 + tkn) * 1024 + 8 * kg;
        const float* am = (const float*)(ws + WS_AM) + (size_t)(layer * 5 + mr) * 1024 + 8 * kg;
        const float* bm = (const float*)(ws + WS_MOD) + (size_t)(layer * 5 + mr) * 6144 + 3 * 1024 + 8 * kg;
        float ss = 0.f;
        { v4u hq[32];
#pragma unroll
          for (int s = 0; s < 32; ++s) hq[s] = *(const GAS v4u*)(hp + 32 * s);
#pragma unroll
          for (int s = 0; s < 32; ++s) { const v4u hw = hq[s]; const float h[8] = {bflo(hw.x), bfhi(hw.x), bflo(hw.y), bfhi(hw.y), bflo(hw.z), bfhi(hw.z), bflo(hw.w), bfhi(hw.w)};
#pragma unroll
              for (int j = 0; j < 8; ++j) ss += h[j] * h[j]; } }
        ss += __shfl_xor(ss, 16); ss += __shfl_xor(ss, 32);
        const float rstd = 1.f / sqrtf(ss * (1.f / 1024.f) + EPS);
        f32x4 acc0 = {0.f, 0.f, 0.f, 0.f}, acc1 = {0.f, 0.f, 0.f, 0.f};
#pragma unroll
        for (int s = 0; s < 32; ++s) {
            if ((s & 7) == 0) asm volatile("" ::: "memory");
            const v4u hw = *(const GAS v4u*)(hp + 32 * s); const f32x4 a0 = *(const GAS f32x4*)(am + 32 * s), a1 = *(const GAS f32x4*)(am + 32 * s + 4);
            const f32x4 b0 = *(const GAS f32x4*)(bm + 32 * s), b1 = *(const GAS f32x4*)(bm + 32 * s + 4);
            const float h[8] = {bflo(hw.x), bfhi(hw.x), bflo(hw.y), bfhi(hw.y), bflo(hw.z), bfhi(hw.z), bflo(hw.w), bfhi(hw.w)};
            const float av[8] = {a0.x, a0.y, a0.z, a0.w, a1.x, a1.y, a1.z, a1.w}, bv[8] = {b0.x, b0.y, b0.z, b0.w, b1.x, b1.y, b1.z, b1.w};
            float u[8];
#pragma unroll
            for (int j = 0; j < 8; ++j) u[j] = h[j] * rstd * av[j] + bv[j];
            v4u hi; hi.x = cvt_pk_bf16(u[0], u[1]); hi.y = cvt_pk_bf16(u[2], u[3]); hi.z = cvt_pk_bf16(u[4], u[5]); hi.w = cvt_pk_bf16(u[6], u[7]);
            v4u lo; lo.x = cvt_pk_bf16(u[0] - bflo(hi.x), u[1] - bfhi(hi.x)); lo.y = cvt_pk_bf16(u[2] - bflo(hi.y), u[3] - bfhi(hi.y));
                    lo.z = cvt_pk_bf16(u[4] - bflo(hi.z), u[5] - bfhi(hi.z)); lo.w = cvt_pk_bf16(u[6] - bflo(hi.w), u[7] - bfhi(hi.w));
            { v2u q; q.x = pk4_fp8(u[0], u[1], u[2], u[3]); q.y = pk4_fp8(u[4], u[5], u[6], u[7]); *(GAS v2u*)((unsigned char*)XN + (size_t)(row0 + tkn) * 1024 + 32 * s + 8 * kg) = q; }
            const bf16x8 uhi = __builtin_bit_cast(bf16x8, hi), ulo = __builtin_bit_cast(bf16x8, lo);
            const bf16x8 rh0 = *(const LAS bf16x8*)(size_t)(fa0 + 64 * s), rh1 = *(const LAS bf16x8*)(size_t)(fa1 + 64 * s), rl0 = *(const LAS bf16x8*)(size_t)(fl0 + 64 * s), rl1 = *(const LAS bf16x8*)(size_t)(fl1 + 64 * s);
            acc0 = __builtin_amdgcn_mfma_f32_16x16x32_bf16(rh0, uhi, acc0, 0, 0, 0); acc0 = __builtin_amdgcn_mfma_f32_16x16x32_bf16(rh0, ulo, acc0, 0, 0, 0); acc0 = __builtin_amdgcn_mfma_f32_16x16x32_bf16(rl0, uhi, acc0, 0, 0, 0);
            acc1 = __builtin_amdgcn_mfma_f32_16x16x32_bf16(rh1, uhi, acc1, 0, 0, 0); acc1 = __builtin_amdgcn_mfma_f32_16x16x32_bf16(rh1, ulo, acc1, 0, 0, 0); acc1 = __builtin_amdgcn_mfma_f32_16x16x32_bf16(rl1, uhi, acc1, 0, 0, 0);
        }
        float kx[8];
#pragma unroll
        for (int r = 0; r < 4; ++r) { const int e0 = 4 * kg + r, e1 = 16 + 4 * kg + r; kx[r] = rt_key(acc0[r] + RB[e0], e0); kx[4 + r] = rt_key(acc1[r] + RB[e1], e1); }
        float tv[4]; int te[4];
#pragma unroll
        for (int k = 0; k < 4; ++k) {
            float m = fmaxf(fmaxf(fmaxf(kx[0], kx[1]), fmaxf(kx[2], kx[3])), fmaxf(fmaxf(kx[4], kx[5]), fmaxf(kx[6], kx[7])));
            m = fmaxf(m, __shfl_xor(m, 16)); m = fmaxf(m, __shfl_xor(m, 32));
            const unsigned mb = __builtin_bit_cast(unsigned, m); const int lowb = (int)(mb & 31u);
            te[k] = (mb >> 31) ? lowb : 31 - lowb; tv[k] = __builtin_bit_cast(float, mb & 0xFFFFFFE0u);
#pragma unroll
            for (int i = 0; i < 8; ++i) kx[i] = (kx[i] == m) ? -3.0e38f : kx[i]; }
        const float x1 = __expf(tv[1] - tv[0]), x2 = __expf(tv[2] - tv[0]), x3 = __expf(tv[3] - tv[0]), inv = 1.f / (1.f + x1 + x2 + x3);
        if (kg == 0) { const float gts[4] = {inv, x1 * inv, x2 * inv, x3 * inv};
#pragma unroll
            for (int k = 0; k < 4; ++k) { const int rk = atomicAdd((int*)(hist + te[k]), 1); const int ri = ((F.wave * 2 + slot) * 16 + tkn) * 4 + k; rec_e[ri] = te[k]; rec_r[ri] = rk; rec_g[ri] = gts[k]; } }
    }
    __syncthreads();
    if (F.tid < 32) base[F.tid] = (int)__hip_atomic_fetch_add(F.ctl + CW_CNT + cnt_slot * 32 + F.tid, (unsigned)hist[F.tid], RLX_AGENT);
    __syncthreads();
    float* TOKG = (float*)(ws + WS_TOKG); int* INV = (int*)(ws + WS_INV);
    for (int i = F.tid; i < 1024; i += 512) { const int w = i >> 7, slot = (i >> 6) & 1, tk = (i >> 2) & 15, k = i & 3; const int task = slot == 0 ? (int)blockIdx.x * 8 + w : ((w == 0 && (blockIdx.x & 3) == 0) ? 2048 + (int)(blockIdx.x >> 2) : 0x7fffffff);
        if (task < ntask) { const int row = task * 16 + tk, e = rec_e[i], sl = base[e] + rec_r[i];
            TOKG[(size_t)row * 4 + k] = rec_g[i]; INV[(size_t)e * NTOK + sl] = row * 4 + k; } }
    __syncthreads();
}

DI void dispatch_phase(Frame& F, int layer) {
    unsigned char* const ws = WSP(F);
    moe_tables(F, layer, 8);
    const LAS int* tab = (const LAS int*)(F.lds + TAB_OFF);
    const int gw = blockIdx.x * 8 + F.wave, NGW = F.G * 8, nrows_all = (layer == 3) ? NLAT : NTOK;
    const int* TOKE = (const int*)(ws + WS_TOKE); const int* TOKS = (const int*)(ws + WS_TOKS);
    const bf16* XN = (const bf16*)(ws + WS_XN); bf16* XR = (bf16*)(ws + WS_XR);
#pragma unroll 2
    for (int row = gw; row < nrows_all; row += NGW) {
        int d = 0; if (F.lane < 4) d = tab[TOKE[(size_t)row * 4 + F.lane]] + TOKS[(size_t)row * 4 + F.lane];
        const v4u x0 = ((const GAS v4u*)(XN + (size_t)row * 1024))[F.lane], x1 = ((const GAS v4u*)(XN + (size_t)row * 1024))[64 + F.lane];
#pragma unroll
        for (int k = 0; k < 4; ++k) { const int dr = __shfl(d, k); GAS v4u* o = (GAS v4u*)(XR + (size_t)dr * 1024); o[F.lane] = x0; o[64 + F.lane] = x1; }
    }
}

DI void combine_phase(Frame& F, CArgsP a, int layer, size_t hdst_off) {
    unsigned char* const ws = WSP(F);
    const int gw = blockIdx.x * 8 + F.wave, NGW = F.G * 8, nrows_all = (layer == 3) ? NLAT : NTOK;
    const float* TOKG = (const float*)(ws + WS_TOKG);
    const bf16* YR = (const bf16*)(ws + WS_YR); const bf16* H = (const bf16*)(ws + WS_H); bf16* HD = (bf16*)(ws + hdst_off); bf16* XN = (bf16*)(ws + WS_XN);
    const float* MOD = (const float*)(ws + WS_MOD);
    const int l = F.lane;
    float g2r[16], Ar[16], Sr[16]; int mr_cur = -1;
#pragma unroll 2
    for (int row = gw; row < nrows_all; row += NGW) {
        const int mr = mod_row(row);
        if (mr != mr_cur) { mr_cur = mr; const float* g2 = MOD + (size_t)(layer * 5 + mr) * 6144 + 5 * 1024;
#pragma unroll
            for (int hb = 0; hb < 2; ++hb) { const int k0 = hb * 512 + 8 * l;
#pragma unroll
                for (int q = 0; q < 2; ++q) { const f32x4 g = *(const GAS f32x4*)(g2 + k0 + 4 * q);
#pragma unroll
                    for (int i = 0; i < 4; ++i) g2r[hb * 8 + q * 4 + i] = g[i];
                    if (layer == 3) { const f32x4 g4 = *(const GAS f32x4*)(a->in[I_FING] + k0 + 4 * q);
#pragma unroll
                        for (int i = 0; i < 4; ++i) { Ar[hb * 8 + q * 4 + i] = g4[i]; Sr[hb * 8 + q * 4 + i] = 0.f; }
                    } else { const float* n1g = a->in[I_N1G] + (layer + 1) * 1024; const float* mp = MOD + (size_t)((layer + 1) * 5 + mr) * 6144;
                        const f32x4 g4 = *(const GAS f32x4*)(n1g + k0 + 4 * q), sh = *(const GAS f32x4*)(mp + k0 + 4 * q), sc = *(const GAS f32x4*)(mp + 1024 + k0 + 4 * q);
#pragma unroll
                        for (int i = 0; i < 4; ++i) { Ar[hb * 8 + q * 4 + i] = g4[i] * (1.f + sc[i]); Sr[hb * 8 + q * 4 + i] = sh[i]; } } } } }
        float gt = 0.f; if (l < 4) gt = TOKG[(size_t)row * 4 + l];
        float f[16];
#pragma unroll
        for (int i = 0; i < 16; ++i) f[i] = 0.f;
#pragma unroll
        for (int k = 0; k < 4; ++k) { const float gk = __shfl(gt, k); const GAS v2u* s = (const GAS v2u*)((const unsigned char*)YR + ((size_t)row * 4 + k) * 1024);
            const v2u y0 = s[l], y1 = s[64 + l]; const unsigned w[4] = {y0.x, y0.y, y1.x, y1.y};
#pragma unroll
            for (int q = 0; q < 4; ++q) { const f32x2 lo = __builtin_amdgcn_cvt_pk_f32_fp8((int)w[q], false), hi = __builtin_amdgcn_cvt_pk_f32_fp8((int)w[q], true);
                f[4 * q] += gk * lo.x; f[4 * q + 1] += gk * lo.y; f[4 * q + 2] += gk * hi.x; f[4 * q + 3] += gk * hi.y; } }
        float hv[16]; float ss = 0.f;
#pragma unroll
        for (int hb = 0; hb < 2; ++hb) { const int k0 = hb * 512 + 8 * l; const v4u hw = *(const GAS v4u*)(H + (size_t)row * 1024 + k0); const unsigned hs[4] = {hw.x, hw.y, hw.z, hw.w};
#pragma unroll
            for (int i = 0; i < 8; ++i) { const float h = (i & 1) ? bfhi(hs[i >> 1]) : bflo(hs[i >> 1]); const float o = h + g2r[hb * 8 + i] * f[hb * 8 + i]; hv[hb * 8 + i] = o; ss += o * o; }
            v4u ow; ow.x = pk2(hv[hb * 8], hv[hb * 8 + 1]); ow.y = pk2(hv[hb * 8 + 2], hv[hb * 8 + 3]); ow.z = pk2(hv[hb * 8 + 4], hv[hb * 8 + 5]); ow.w = pk2(hv[hb * 8 + 6], hv[hb * 8 + 7]);
            *(GAS v4u*)(HD + (size_t)row * 1024 + k0) = ow; }
        const float rstd = 1.f / sqrtf(wave_sum(ss) * (1.f / 1024.f) + EPS);
        if (layer == 3) {
#pragma unroll
            for (int hb = 0; hb < 2; ++hb)
#pragma unroll
                for (int q = 0; q < 2; ++q) { const int k0 = hb * 512 + 8 * l + 4 * q; f32x4 o;
#pragma unroll
                    for (int i = 0; i < 4; ++i) o[i] = hv[hb * 8 + q * 4 + i] * rstd * Ar[hb * 8 + q * 4 + i];
                    *(GAS f32x4*)(a->out + (size_t)row * 1024 + k0) = o; }
        } else {
#pragma unroll
            for (int hb = 0; hb < 2; ++hb) { const int k0 = hb * 512 + 8 * l; float y[8];
#pragma unroll
                for (int i = 0; i < 8; ++i) y[i] = hv[hb * 8 + i] * rstd * Ar[hb * 8 + i] + Sr[hb * 8 + i];
                v4u o; o.x = pk2(y[0], y[1]); o.y = pk2(y[2], y[3]); o.z = pk2(y[4], y[5]); o.w = pk2(y[6], y[7]);
                *(GAS v4u*)(XN + (size_t)row * 1024 + k0) = o; }
        }
    }
}
constexpr int N_PHASES = 2 + 11 * 4;
#ifndef MK_REP
#define MK_REP 0
#endif
#ifndef MK_MULTI
#define MK_MULTI 0
#endif

__global__ void __launch_bounds__(512, 2) mega_fwd(Args args) {
    extern __shared__ __attribute__((aligned(16))) unsigned char lds_raw[];
    Frame F;
    F.lds = (LAS unsigned char*)lds_raw; F.MISC = (volatile LAS unsigned*)(F.lds + MISC_OFF);
    F.wave = __builtin_amdgcn_readfirstlane((int)threadIdx.x >> 6); F.lane = lane_id(); F.tid = F.wave * 64 + F.lane;
    F.G = gridDim.x; F.vcu = blockIdx.x; F.ws = kargs()->ws; F.ctl = (gu32*)(F.ws + WS_CTL);
    if (F.tid < 64) F.MISC[F.tid] = 0u;
    __syncthreads();
    const int lo = kargs()->ph_lo, hi = kargs()->ph_hi;
    XcdBarrier bar; bar.bar = (unsigned*)(F.ctl + CW_BAR); bar.x = 0; bar.st = nullptr; bar.wv = F.wave;
    if (hi - lo > 1) bar = xcd_barrier_post((unsigned*)(F.ctl + CW_BAR), F.MISC + 8, F.wave);
#ifndef MK_ONLY
#define MK_ONLY 0xFFFFFFFFu
#endif
#define IN(k) (lo <= (k) && (k) < hi)
#define ON(bit) ((MK_ONLY >> (bit)) & 1u)
#define SEAM(k) do { if ((k) + 1 < hi) xcd_barrier(bar); } while (0)
    const int G = F.G, bid = (G % 8 == 0) ? (int)((blockIdx.x & 7) * (G >> 3) + (blockIdx.x >> 3)) : (int)blockIdx.x, rbid = G - 1 - bid, repm = kargs()->rep;
            constexpr size_t T1024 = 256 * 1024 * 2, T768 = 256 * 768 * 2, T512 = 256 * 512 * 2;

    if (ON(0) && IN(0)) for (int rr_ = 0, nr_ = 1 + ((repm >> 0) & 1); rr_ < nr_; ++rr_) { { Frame Fp = refresh(F); prologue0(Fp, kargs()); } SEAM(0); }
    if (ON(1) && IN(1)) for (int rr_ = 0, nr_ = 1 + ((repm >> 1) & 1); rr_ < nr_; ++rr_) { { Frame Fp = refresh(F); prologue1(Fp, kargs()); } SEAM(1); }

#pragma unroll 1
    for (int L = 0; L < 4; ++L) {
        const int pb = 2 + 11 * L, j = L >> 1;
#define ws WSP(F)
#define MOD ((const float*)(WSP(F) + WS_MOD))
        if ((L & 1) == 0) {
            if (ON(2) && IN(pb + 0)) for (int rr_ = 0, nr_ = 1 + ((repm >> 2) & 1); rr_ < nr_; ++rr_) {
                { pg8::Gemm g{1024, 1024, 1024, F.wave}; PlainOrder S{(const char*)(ws + WS_XN), (const char*)(ws + WS_WEV_S5) + (size_t)j * 768 * 1024 * 2, T1024, T1024, 132, 3, G, bid, 3};
                  EpiUG E{(bf16*)(ws + WS_UG)}; pg8::gemm_phase(F.lds, g, S, E); }
                { pg8::Gemm g{1024, 1024, 1024, F.wave}; PlainOrder S{(const char*)(ws + WS_WEV_PQ) + (size_t)j * 512 * 1024 * 2, (const char*)(ws + WS_XN), T1024, T1024, 2, 132, G, rbid, 16};
                  EpiPQt E{(bf16*)(ws + WS_PQT)}; pg8::gemm_phase(F.lds, g, S, E); }
                SEAM(pb + 0);
            }
            if (ON(3) && IN(pb + 1)) for (int rr_ = 0, nr_ = 1 + ((repm >> 3) & 1); rr_ < nr_; ++rr_) {
                { pg8::Gemm g{512, 768, 512, F.wave}; GroupOrder S{(const char*)(ws + WS_UG), (const char*)(ws + WS_EOUT) + (size_t)j * 48 * 256 * 512 * 2, T768, T512, (size_t)S5ROWS * S5K * 2, (size_t)256 * 512 * 2, 5, 1, 48, G, bid};
                  EpiSloc E{(float*)(ws + WS_SLOC)}; pg8::gemm_phase(F.lds, g, S, E); }
                { Frame Fp = refresh(F); fft_phase(Fp, true); }
                SEAM(pb + 1);
            }
            if (ON(4) && IN(pb + 2)) for (int rr_ = 0, nr_ = 1 + ((repm >> 4) & 1); rr_ < nr_; ++rr_) { { Frame Fp = refresh(F); s5_carry_phase(Fp, j); } SEAM(pb + 2); }
            if (ON(5) && IN(pb + 3)) for (int rr_ = 0, nr_ = 1 + ((repm >> 5) & 1); rr_ < nr_; ++rr_) {
                pg8::Gemm g{768, 768, 768, F.wave}; GroupOrder S{(const char*)(ws + WS_UG), (const char*)(ws + WS_WC) + (size_t)j * 48 * 512 * 768 * 2, T768, T768, (size_t)S5ROWS * S5K * 2, (size_t)512 * 768 * 2, 5, 2, 48, G, bid};
                EpiS5Out E{(bf16*)(ws + WS_YB)}; pg8::gemm_phase(F.lds, g, S, E);
                SEAM(pb + 3);
            }
            if (ON(6) && IN(pb + 4)) for (int rr_ = 0, nr_ = 1 + ((repm >> 6) & 1); rr_ < nr_; ++rr_) {
                pg8::Gemm g{768, 768, 768, F.wave}; PlainOrder S{(const char*)(ws + WS_YB), (const char*)(ws + WS_GLUW) + (size_t)j * 768 * 768 * 2, T768, T768, 132, 3, G, bid, 3};
                EpiGLU E{(const bf16*)(ws + WS_YB), (const bf16*)(ws + WS_B1H + 768 * 1024) + j * 768, (bf16*)(ws + WS_CAT)}; pg8::gemm_phase(F.lds, g, S, E);
                SEAM(pb + 4);
            }
            if (ON(7) && IN(pb + 5)) for (int rr_ = 0, nr_ = 1 + ((repm >> 7) & 1); rr_ < nr_; ++rr_) {
                pg8::Gemm g{512, 512, 64, F.wave, 32768}; PlainOrder S{(const char*)(ws + WS_CAT), (const char*)(ws + WS_WEV_OUT) + (size_t)j * 1048576, T512, T512, 132, 4, G, bid, 4, (const char*)(ws + WS_SC3) + (size_t)j * 32768, true};
                EpiResid E{(bf16*)(ws + WS_H), MOD + (size_t)L * 5 * 6144 + 2048}; pg8::gemm_phase<EpiResid, PlainOrder, false, true>(F.lds, g, S, E);
                SEAM(pb + 5);
            }
        } else {
            if (ON(8) && IN(pb + 0)) for (int rr_ = 0, nr_ = 1 + ((repm >> 8) & 1); rr_ < nr_; ++rr_) {
                { pg8::Gemm g{1024, 1024, 1024, F.wave}; PlainOrder S{(const char*)(ws + WS_XN), (const char*)(ws + WS_WOD_IN) + (size_t)j * 2560 * 1024 * 2, T1024, T1024, 132, 8, G, bid, 4, nullptr, true};
                  EpiOddIn E{(bf16*)(ws + WS_U), (bf16*)(ws + WS_VS), (bf16*)(ws + WS_Q), (bf16*)(ws + WS_KALL), (const float*)(ws + WS_ROPE), 0.125f * 1.4426950408889634f}; pg8::gemm_phase(F.lds, g, S, E); }
                { pg8::Gemm g{1024, 1024, 1024, F.wave}; PlainOrder S{(const char*)(ws + WS_WOD_IN) + ((size_t)j * 2560 + 2048) * 1024 * 2, (const char*)(ws + WS_XN), T1024, T1024, 2, 132, G, rbid, 16, nullptr, true};
                  EpiVT E{(bf16*)(ws + WS_VT)}; pg8::gemm_phase(F.lds, g, S, E); }
                SEAM(pb + 0);
            }
            if (ON(9) && IN(pb + 1)) for (int rr_ = 0, nr_ = 1 + ((repm >> 9) & 1); rr_ < nr_; ++rr_) {
                const int natt = (L == 1) ? 528 : 512;
                Frame Fp = refresh(F);
                for (int u = bid; u < natt; u += G) {
                    if (u < 512) attn_unit(Fp, kargs(), j, L, (u >> 7) * SEQ + (u & 31) * 256, u >> 7, (u >> 5) & 3, KV_LEN);
                    else { const int v = u - 512; attn_unit(Fp, kargs(), j, L, NLAT + (v >> 2) * CTXL, v >> 2, v & 3, CTXL); }
                }
                const int nsgu = ((L == 1) ? 264 : 256) * 4;
                for (int u = rbid; u < nsgu; u += G) sgu_unit(Fp, kargs(), j, u >> 2, u & 3);
                SEAM(pb + 1);
            }
            if (ON(10) && IN(pb + 2)) for (int rr_ = 0, nr_ = 1 + ((repm >> 10) & 1); rr_ < nr_; ++rr_) {
                pg8::Gemm g{512, 512, 64, F.wave, 32768}; PlainOrder S{(const char*)(ws + WS_CAT), (const char*)(ws + WS_WOD_OUT) + (size_t)j * 1048576, T512, T512, (L == 3) ? 128 : 132, 4, G, bid, 4, (const char*)(ws + WS_SC3) + 65536 + (size_t)j * 32768, true};
                EpiResid E{(bf16*)(ws + WS_H), MOD + (size_t)L * 5 * 6144 + 2048}; pg8::gemm_phase<EpiResid, PlainOrder, false, true>(F.lds, g, S, E);
                SEAM(pb + 2);
            }
        }
        if (ON(11) && IN(pb + 6)) for (int rr_ = 0, nr_ = 1 + ((repm >> 11) & 1); rr_ < nr_; ++rr_) { { Frame Fp = refresh(F); router_phase(Fp, kargs(), L, (rr_ + 1 < nr_) ? L + 4 : L); } SEAM(pb + 6); }
        if (ON(13) && IN(pb + 8)) for (int rr_ = 0, nr_ = 1 + ((repm >> 13) & 1); rr_ < nr_; ++rr_) {
            { Frame Fp = refresh(F); moe_tables(Fp, L, 8); }
            pg8::Gemm g{512, 512, 64, F.wave, 32768}; MoeOrder S{(const char*)(ws + WS_XN), (const char*)(ws + WS_W1T) + (size_t)L * 32 * 2048 * 1024, (size_t)2048 * 1024, T512, 8, G, bid, (const LAS int*)(F.lds + TAB_OFF), (const int*)(ws + WS_INV), true, (const char*)(ws + WS_SC1) + (size_t)L * 32 * 65536, 65536};
            EpiSwiglu E{(const bf16*)(ws + WS_B1H) + (size_t)L * 32 * 2048, (bf16*)(ws + WS_ACT)};
            pg8::gemm_phase<EpiSwiglu, MoeOrder, true, true>(F.lds, g, S, E);
            SEAM(pb + 8);
        }
        if (ON(14) && IN(pb + 9)) for (int rr_ = 0, nr_ = 1 + ((repm >> 14) & 1); rr_ < nr_; ++rr_) {
            { Frame Fp = refresh(F); moe_tables(Fp, L, 4); }
            pg8::Gemm g{512, 512, 64, F.wave, 32768}; MoeOrder S{(const char*)(ws + WS_ACT), (const char*)(ws + WS_W2T) + (size_t)L * 32 * 1024 * 1024, (size_t)1024 * 1024, T512, 4, G, bid, (const LAS int*)(F.lds + TAB_OFF), (const int*)(ws + WS_INV), false, (const char*)(ws + WS_SC2) + (size_t)L * 32 * 32768, 32768};
            EpiMoe2 E{(const bf16*)(ws + WS_B1H + 512 * 1024) + (size_t)L * 32 * 1024, (bf16*)(ws + WS_YR)}; pg8::gemm_phase<EpiMoe2, MoeOrder, false, true>(F.lds, g, S, E);
            SEAM(pb + 9);
        }
        if (ON(15) && IN(pb + 10)) for (int rr_ = 0, nr_ = 1 + ((repm >> 15) & 1); rr_ < nr_; ++rr_) { { Frame Fp = refresh(F); combine_phase(Fp, kargs(), L, (rr_ + 1 < nr_) ? WS_PQT : WS_H); } SEAM(pb + 10); }
    }
#undef ws
#undef MOD
#undef IN
#undef SEAM
}

extern "C" void kernel_launch(void* const* d_in, const int* in_sizes, int n_in, void* d_out, int out_size, void* d_ws, size_t ws_size, hipStream_t stream) {
    static int grid = 0;
    if (grid == 0) {
        if (n_in != 38 || out_size != NLAT * DM || ws_size < WS_END) { fprintf(stderr, "kernel_launch: unexpected shapes (n_in %d, out %d, ws %zu)\n", n_in, out_size, ws_size); grid = -1; return; }
        int dev = 0, cus = 0;
        if (hipGetDevice(&dev) != hipSuccess || hipDeviceGetAttribute(&cus, hipDeviceAttributeMultiprocessorCount, dev) != hipSuccess) { grid = -1; return; }
        if (hipFuncSetAttribute((const void*)mega_fwd, hipFuncAttributeMaxDynamicSharedMemorySize, LDS_BYTES) != hipSuccess) { fprintf(stderr, "kernel_launch: hipFuncSetAttribute failed\n"); grid = -1; return; }
        (void)hipGetLastError();
        grid = cus;
        if (grid != 256) { fprintf(stderr, "kernel_launch: %d CUs; this kernel is built for 256\n", grid); grid = -1; return; }
    }
    if (grid < 0) return;
    if (hipMemsetAsync((char*)d_ws + WS_CTL, 0, CTL_ZERO_BYTES, stream) != hipSuccess) return;
    Args a{};
    for (int i = 0; i < 38; ++i) a.in[i] = (const float*)d_in[i];
    a.out = (float*)d_out; a.ws = (unsigned char*)d_ws; a.rep = MK_REP; a.pad = 0;
#if MK_MULTI
    for (int p = 0; p < N_PHASES; ++p) {
        if (p >= 2) { const int L = (p - 2) / 11, q = (p - 2) % 11; if (((L & 1) && q >= 3 && q <= 5) || q == 7) continue; }
        a.ph_lo = p; a.ph_hi = p + 1;
        hipLaunchKernelGGL(mega_fwd, dim3(grid), dim3(512), LDS_BYTES, stream, a);
    }
#else
    a.ph_lo = 0; a.ph_hi = N_PHASES;
    hipLaunchKernelGGL(mega_fwd, dim3(grid), dim3(512), LDS_BYTES, stream, a);
#endif
}
```

```cpp
#include <hip/hip_runtime.h>
#include <stdio.h>

#define GAS __attribute__((address_space(1)))
#define LAS __attribute__((address_space(3)))
typedef unsigned short bf16;
typedef unsigned v4u __attribute__((ext_vector_type(4)));
typedef unsigned v2u __attribute__((ext_vector_type(2)));
typedef float f32x4 __attribute__((ext_vector_type(4)));
typedef float f32x2 __attribute__((ext_vector_type(2)));
typedef float f32x16 __attribute__((ext_vector_type(16)));
typedef short bf16x8 __attribute__((ext_vector_type(8)));
typedef short s16x4 __attribute__((ext_vector_type(4)));
typedef int v8i __attribute__((ext_vector_type(8)));
typedef int v4i __attribute__((ext_vector_type(4)));
typedef GAS unsigned gu32;
#define RLX_AGENT __ATOMIC_RELAXED, __HIP_MEMORY_SCOPE_AGENT
#define DI __device__ __forceinline__

constexpr int NLAT = 32768, NCTX = 1024, NTOK = NLAT + NCTX, DM = 1024, SEQ = 8192, CTXL = 256, NB = 4;
constexpr int NEXP = 32, TOPK = 4;
constexpr float EPS = 1e-6f;
constexpr int S5T = 32;
constexpr int S5ROWS = 1280;
constexpr int S5K = 768;
constexpr int XR_ROWS = 143360;
constexpr int KV_LEN = 8448;

constexpr size_t MiB = 1u << 20;
constexpr size_t WS_CTL = 0, CTL_ZERO_BYTES = 2 * MiB;
constexpr size_t WS_MOD = 2 * MiB;
constexpr size_t WS_AM = 2 * MiB + 524288;
constexpr size_t WS_CB = 2 * MiB + 524288 + 131072;
constexpr size_t WS_ROPE = 3 * MiB;
constexpr size_t WS_TW = 3 * MiB + 65536;
constexpr size_t WS_APT = 3 * MiB + 131072;
constexpr size_t WS_H = 4 * MiB;
constexpr size_t WS_XN = 136 * MiB;
constexpr size_t WS_CAT = 202 * MiB;
constexpr size_t WS_WEV_S5 = 268 * MiB;
constexpr size_t WS_WEV_PQ = 271 * MiB;
constexpr size_t WS_WEV_OUT = 273 * MiB;
constexpr size_t WS_GLUW = 277 * MiB;
constexpr size_t WS_WOD_IN = 280 * MiB;
constexpr size_t WS_WOD_OUT = 290 * MiB;
constexpr size_t WS_SGUW = 294 * MiB;
constexpr size_t WS_WC = 295 * MiB;
constexpr size_t WS_EOUT = 367 * MiB;
constexpr size_t WS_W1T = 392 * MiB;
constexpr size_t WS_SC1 = 648 * MiB;
constexpr size_t WS_SC2 = 660 * MiB;
constexpr size_t WS_SC3 = 664 * MiB;
constexpr int RT_PITCH = 2064;
constexpr size_t WS_RIMG = 666 * MiB;
constexpr size_t WS_B1H = 665 * MiB;
constexpr size_t WS_W2T = 904 * MiB;
constexpr size_t WS_PQT = 1160 * MiB;
constexpr size_t WS_UG = 1193 * MiB;
constexpr size_t WS_SLOC = 1283 * MiB;
constexpr size_t WS_YB = 1343 * MiB;
constexpr size_t WS_U = 1160 * MiB;
constexpr size_t WS_VS = 1193 * MiB;
constexpr size_t WS_Q = 1226 * MiB;
constexpr size_t WS_KALL = 1259 * MiB;
constexpr size_t WS_VT = 1292 * MiB;
constexpr size_t WS_TOKE = 1393 * MiB;
constexpr size_t WS_TOKS = 1394 * MiB;
constexpr size_t WS_TOKG = 1395 * MiB;
constexpr size_t WS_XR = 1396 * MiB;
constexpr size_t WS_INV = 1396 * MiB;
constexpr size_t WS_ACT = 1676 * MiB;
constexpr size_t WS_YR = 1956 * MiB;
constexpr size_t WS_DBG = 2236 * MiB;
constexpr size_t WS_END = 2240 * MiB;

constexpr int CW_TMO = 0, CW_CODE = 1;
constexpr int CW_BAR = 4096;
constexpr int CW_CNT = 16384;
constexpr int CW_CHK = 32768;

constexpr int RING_BYTES = 131072;
constexpr int TAB_OFF = 154112;
constexpr int MISC_OFF = 155136;
constexpr int LDS_BYTES = 155648;

DI unsigned f2bf(float f) { unsigned u = __builtin_bit_cast(unsigned, f); return (u + 0x7fffu + ((u >> 16) & 1u)) >> 16; }
DI unsigned pk2(float lo, float hi) { return f2bf(lo) | (f2bf(hi) << 16); }
DI float bf2f(unsigned b) { return __builtin_bit_cast(float, b << 16); }
DI float bflo(unsigned w) { return __builtin_bit_cast(float, w << 16); }
DI float bfhi(unsigned w) { return __builtin_bit_cast(float, w & 0xffff0000u); }
DI unsigned cvt_pk_bf16(float lo, float hi) { unsigned r; asm volatile("v_cvt_pk_bf16_f32 %0, %1, %2" : "=v"(r) : "v"(lo), "v"(hi)); return r; }
DI int lane_id() { int l; asm volatile("v_mbcnt_lo_u32_b32 %0, -1, 0\n\tv_mbcnt_hi_u32_b32 %0, -1, %0" : "=v"(l)); return l; }
template <class T> DI T my_shfl_idx(T v, int src) { return __builtin_bit_cast(T, __builtin_amdgcn_ds_bpermute(src << 2, __builtin_bit_cast(int, v))); }
template <class T> DI T my_shfl_xor(T v, int m) { return my_shfl_idx(v, lane_id() ^ m); }
template <class T> DI T my_shfl(T v, int src) { return my_shfl_idx(v, src); }
template <class T> DI T my_shfl_up(T v, int d, int w) { const int self = lane_id(); int idx = self - d; idx = idx < (self & ~(w - 1)) ? self : idx; return my_shfl_idx(v, idx); }
#define __shfl_xor my_shfl_xor
#define __shfl my_shfl
#define __shfl_up my_shfl_up
DI float wave_sum(float v) {
#pragma unroll
    for (int o = 1; o < 64; o <<= 1) v += __shfl_xor(v, o);
    return v;
}
template <int CTRL> DI float dpp_f(float v) { return __builtin_bit_cast(float, __builtin_amdgcn_update_dpp(0, __builtin_bit_cast(int, v), CTRL, 0xF, 0xF, true)); }
template <int MASK> DI float xor_lane(float v, int lane) {
    if constexpr (MASK == 1) return dpp_f<0xB1>(v);
    else if constexpr (MASK == 2) return dpp_f<0x4E>(v);
    else if constexpr (MASK == 4) return dpp_f<0x1B>(dpp_f<0x141>(v));
    else if constexpr (MASK == 8) return dpp_f<0x128>(v);
    else return __shfl_xor(v, MASK);
}
DI float fast_exp2(float x) { return __builtin_amdgcn_exp2f(x); }
DI float fast_rcp(float x) { return __builtin_amdgcn_rcpf(x); }
DI unsigned char f8_1(float a) { a = __builtin_amdgcn_fmed3f(a, -448.f, 448.f); return (unsigned char)(__builtin_amdgcn_cvt_pk_fp8_f32(a, a, 0, false) & 0xFF); }
DI unsigned pk4_fp8_nc(float a, float b, float c, float d) { int p = __builtin_amdgcn_cvt_pk_fp8_f32(a, b, 0, false); p = __builtin_amdgcn_cvt_pk_fp8_f32(c, d, p, true); return (unsigned)p; }
DI unsigned pk4_fp8(float a, float b, float c, float d) { a = __builtin_amdgcn_fmed3f(a, -448.f, 448.f); b = __builtin_amdgcn_fmed3f(b, -448.f, 448.f); c = __builtin_amdgcn_fmed3f(c, -448.f, 448.f); d = __builtin_amdgcn_fmed3f(d, -448.f, 448.f);
    int p = __builtin_amdgcn_cvt_pk_fp8_f32(a, b, 0, false); p = __builtin_amdgcn_cvt_pk_fp8_f32(c, d, p, true); return (unsigned)p; }
DI float sigmoidf_(float x) { return fast_rcp(1.f + fast_exp2(-1.4426950408889634f * x)); }
DI float gelu_tanh(float x) { const float C1 = -2.f * 0.7978845608028654f * 1.4426950408889634f, C2 = C1 * 0.044715f; return x * fast_rcp(1.f + fast_exp2(x * (x * x * C2 + C1))); }
DI float silu_(float x) { return x * sigmoidf_(x); }
#define LDS_WAIT() asm volatile("s_waitcnt lgkmcnt(0)" ::: "memory")
#define VM_WAIT() asm volatile("s_waitcnt vmcnt(0)" ::: "memory")

#define XB_TMO      128
#define XB_XCNT(j)  (256  + 64 * (j))
#define XB_XSUB(j)  (1280 + 64 * (j))
#define XB_XGEN(j)  (2304 + 64 * (j))
#define XB_TOP      3328
#define XB_TOPGEN   3392
#define XCD_BAR_WORDS 3456
#define XB_SPIN_CAP (1u << 18)
DI unsigned xb_ld(unsigned* p)              { return __hip_atomic_load(p, __ATOMIC_RELAXED, __HIP_MEMORY_SCOPE_AGENT); }
DI unsigned xb_add(unsigned* p, unsigned v) { return __hip_atomic_fetch_add(p, v, __ATOMIC_RELAXED, __HIP_MEMORY_SCOPE_AGENT); }
DI unsigned xb_xcc_id() { return (unsigned)__builtin_amdgcn_s_getreg((3 << 11) | 20) & 0xFu; }
#define XB_SPIN(cond, bar) do { unsigned _sp = 0; while (cond) { __builtin_amdgcn_s_sleep(1); \
    if ((++_sp & 255u) == 0u) { if (xb_ld(&(bar)[XB_TMO])) break; if (_sp > XB_SPIN_CAP) { atomicAdd(&(bar)[XB_TMO], 1u); break; } } } } while (0)
struct XcdBarrier { unsigned* bar; unsigned x; volatile LAS unsigned* st; int wv; };
DI XcdBarrier xcd_barrier_post(unsigned* bar, volatile LAS unsigned* st, int wv) {
    XcdBarrier b; b.bar = bar; b.x = xb_xcc_id(); b.st = st; b.wv = wv;
    if (wv == 0 && lane_id() == 0) (void)xb_add(&bar[XB_XCNT(b.x)], 1u);
    return b;
}
DI void xcd_barrier_complete(unsigned* bar, unsigned x, unsigned& nloc, unsigned& nx) {
    const unsigned G = gridDim.x * gridDim.y * gridDim.z;
    unsigned sum, cnt, mine, sp = 0u;
    for (;;) {
        sum = 0u; cnt = 0u; mine = 0u;
#pragma unroll
        for (unsigned j = 0; j < 16; ++j) { const unsigned c = xb_ld(&bar[XB_XCNT(j)]); sum += c; cnt += (c > 0u) ? 1u : 0u; mine = (j == x) ? c : mine; }
        if (sum == G) break;
        __builtin_amdgcn_s_sleep(1);
        if ((++sp & 255u) == 0u) { if (xb_ld(&bar[XB_TMO])) break; if (sp > XB_SPIN_CAP) { atomicAdd(&bar[XB_TMO], 1u); break; } }
    }
    nloc = mine > 0u ? mine : 1u; nx = cnt > 0u ? cnt : 1u;
}
DI void xcd_barrier(const XcdBarrier& b) {
    asm volatile("s_waitcnt vmcnt(0)" ::: "memory");
    __syncthreads();
    if (b.wv == 0 && lane_id() == 0) {
        unsigned* bar = b.bar;
        __builtin_amdgcn_s_waitcnt(0);
        unsigned nloc = b.st[0], nx = b.st[1];
        if (nloc == 0u) { xcd_barrier_complete(bar, b.x, nloc, nx); b.st[0] = nloc; b.st[1] = nx; }
        const unsigned old = xb_add(&bar[XB_XSUB(b.x)], 1u);
        const unsigned gen = old / nloc;
        if (old + 1u == (gen + 1u) * nloc) {
            __builtin_amdgcn_fence(__ATOMIC_RELEASE, "agent");
            asm volatile("s_waitcnt vmcnt(0)" ::: "memory");
            const unsigned og = xb_add(&bar[XB_TOP], 1u);
            const unsigned tg = og / nx;
            if (og + 1u == (tg + 1u) * nx) xb_add(&bar[XB_TOPGEN], 1u);
            else XB_SPIN(xb_ld(&bar[XB_TOPGEN]) == tg, bar);
            __builtin_amdgcn_fence(__ATOMIC_ACQUIRE, "agent");
            xb_add(&bar[XB_XGEN(b.x)], 1u);
            asm volatile("s_waitcnt vmcnt(0)" ::: "memory");
        } else {
            XB_SPIN(xb_ld(&bar[XB_XGEN(b.x)]) == gen, bar);
            __builtin_amdgcn_fence(__ATOMIC_ACQUIRE, "agent");
            asm volatile("s_waitcnt vmcnt(0)" ::: "memory");
        }
    }
    __syncthreads();
}

namespace pg8 {
constexpr int BM = 256, BK = 64, HALF = 128, HTB = HALF * BK * 2, STAGE_BYTES = 8 * HTB;
__host__ __device__ __forceinline__ int lds_byte(int r, int c) { const int st = (r >> 4) * 2 + (c >> 5), rr = r & 15, cc = c & 31, ob = rr * 64 + cc * 2; return st * 1024 + (ob ^ (((ob >> 9) & 1) << 5)); }
__host__ __device__ __forceinline__ void stage_rc(int b, int& R, int& C) { const int st = b / 1024, sb = b % 1024, swz = sb ^ (((sb >> 9) & 1) << 5); R = (st >> 1) * 16 + swz / 64; C = (st & 1) * 32 + (swz % 64) / 2; }
__host__ __device__ __forceinline__ int perm32(int rho) { const int n = rho >> 4, i = rho & 15; return 8 * (i >> 2) + 4 * n + (i & 3); }
struct Unit { const char* A; const char* B; int pm, pn, g, aux; const int* rowidx; int nvalid; const char* S; int half = 0, roff = 0; };
struct Gemm { int K, lda, ldb, wv; int kstepB = 128; };

DI unsigned ld_hidden(const char* base, unsigned off) { unsigned r; asm volatile("global_load_dword %0, %1, %2" : "=v"(r) : "v"(off), "s"(base) : "memory"); return r; }
template <int BYTE> DI void mfma_f8(f32x4& acc, const v8i w, const v8i x, unsigned sw, unsigned sx) {
    if constexpr (BYTE == 0) asm volatile("v_mfma_scale_f32_16x16x128_f8f6f4 %0, %1, %2, %0, %3, %4 op_sel_hi:[0,0,0]" : "+v"(acc) : "v"(w), "v"(x), "v"(sw), "v"(sx));
    else if constexpr (BYTE == 1) asm volatile("v_mfma_scale_f32_16x16x128_f8f6f4 %0, %1, %2, %0, %3, %4 op_sel:[1,0,0] op_sel_hi:[0,0,0]" : "+v"(acc) : "v"(w), "v"(x), "v"(sw), "v"(sx));
    else if constexpr (BYTE == 2) asm volatile("v_mfma_scale_f32_16x16x128_f8f6f4 %0, %1, %2, %0, %3, %4 op_sel_hi:[1,0,0]" : "+v"(acc) : "v"(w), "v"(x), "v"(sw), "v"(sx));
    else asm volatile("v_mfma_scale_f32_16x16x128_f8f6f4 %0, %1, %2, %0, %3, %4 op_sel:[1,0,0] op_sel_hi:[1,0,0]" : "+v"(acc) : "v"(w), "v"(x), "v"(sw), "v"(sx));
}
template <class Epi, class Sched, bool GATHER = false, bool F8 = false>
DI void gemm_phase(LAS unsigned char* lds, const Gemm g, const Sched& S, const Epi& E) {
    int tid_ = g.wv * 64 + lane_id(); asm volatile("" : "+v"(tid_));
    const int tid = tid_, wid = __builtin_amdgcn_readfirstlane(tid >> 6), lane = tid & 63, wr = wid >> 2, wc = wid & 3, fr = lane & 15, fq = lane >> 4;
    const int K = g.K, nt = K / BK;
    unsigned voffA[2], voffB[2];
#pragma unroll
    for (int i = 0; i < 2; ++i) { int R, C; stage_rc(tid * 16 + i * 8192, R, C); const int Rb = Epi::PERM ? ((R & ~31) + perm32(R & 31)) : R;
        voffA[i] = (unsigned)(R * g.lda + C) * 2u; voffB[i] = (unsigned)(Rb * g.ldb + C) * 2u; }
    const size_t kstep = (size_t)(BK * 2), kstepB = (size_t)g.kstepB;
    const size_t hstepA = GATHER ? (size_t)0 : (size_t)HALF * g.lda * 2, hstepB = (size_t)HALF * g.ldb * 2;
    int gR[2]; unsigned gC[2];
#pragma unroll
    for (int i = 0; i < 2; ++i) { int R, C; stage_rc(tid * 16 + i * 8192, R, C); gR[i] = R; gC[i] = (unsigned)C * 2u; }
    unsigned gcur[2][2], gnxt[2][2];
#define PG8_GRAW(dst, u) do { int t_ = tid; asm volatile("" : "+v"(t_));   \
        _Pragma("unroll") for (int h_ = 0; h_ < 2; ++h_) _Pragma("unroll") for (int i_ = 0; i_ < 2; ++i_) { int R_, C_; stage_rc(t_ * 16 + i_ * 8192, R_, C_); const int rr_ = (u).roff + h_ * HALF + R_; \
        dst[h_][i_] = ld_hidden((const char*)(u).rowidx, (unsigned)(rr_ < (u).nvalid ? rr_ : (u).nvalid - 1) * 4u); } } while (0)
#define PG8_GFIN(dst, src) do { _Pragma("unroll") for (int h_ = 0; h_ < 2; ++h_) _Pragma("unroll") for (int i_ = 0; i_ < 2; ++i_) dst[h_][i_] = (src[h_][i_] >> 2) * (unsigned)(g.lda * 2) + gC[i_]; } while (0)
    const unsigned ldsw = (unsigned)wid * 1024u;
    const int aoff = lds_byte(wr * 64 + fr, fq * 8), boff = lds_byte(wc * 32 + fr, fq * 8);
#define PG8_SA(b, h) (((b) * 2 + (h)) * HTB)
#define PG8_SB(b, h) ((4 + (b) * 2 + (h)) * HTB)
#define PG8_STAGE(bufoff, gbase, voff) do { _Pragma("unroll") for (int _i = 0; _i < 2; ++_i) \
        __builtin_amdgcn_global_load_lds((const unsigned*)((const char*)(gbase) + (voff)[_i]), (LAS unsigned*)(lds + (bufoff) + ldsw + _i * 8192), 16, 0, 0); } while (0)
#define PG8_STAGE_A(bufoff, gbase, h, OFFS) do { if constexpr (GATHER) { PG8_STAGE(bufoff, gbase, OFFS[h]); } else { PG8_STAGE(bufoff, (gbase) + (h) * hstepA, voffA); } } while (0)
#define PG8_LDA(dst, b, h) do { _Pragma("unroll") for (int m = 0; m < 4; ++m) _Pragma("unroll") for (int k = 0; k < 2; ++k) dst[m][k] = *(const LAS bf16x8*)(lds + PG8_SA(b, h) + aoff + m * 2048 + k * 1024); } while (0)
#define PG8_LDB(dst, b, h) do { _Pragma("unroll") for (int n = 0; n < 2; ++n) _Pragma("unroll") for (int k = 0; k < 2; ++k) dst[n][k] = *(const LAS bf16x8*)(lds + PG8_SB(b, h) + boff + n * 2048 + k * 1024); } while (0)
#define PG8_CAT(x) __builtin_shufflevector(__builtin_bit_cast(v4i, x[0]), __builtin_bit_cast(v4i, x[1]), 0, 1, 2, 3, 4, 5, 6, 7)
#define PG8_MMA(ai, bj, At, Bt, SW) do { __builtin_amdgcn_s_setprio(1); _Pragma("unroll") for (int m = 0; m < 4; ++m) { \
        if constexpr (F8) { mfma_f8<(bj) * 2 + 0>(acc[ai][bj][m][0], PG8_CAT(Bt[0]), PG8_CAT(At[m]), SW, 0x7F7F7F7Fu); mfma_f8<(bj) * 2 + 1>(acc[ai][bj][m][1], PG8_CAT(Bt[1]), PG8_CAT(At[m]), SW, 0x7F7F7F7Fu); } \
        else { _Pragma("unroll") for (int n = 0; n < 2; ++n) _Pragma("unroll") for (int k = 0; k < 2; ++k) acc[ai][bj][m][n] = __builtin_amdgcn_mfma_f32_16x16x32_bf16(Bt[n][k], At[m][k], acc[ai][bj][m][n], 0, 0, 0); } } __builtin_amdgcn_s_setprio(0); } while (0)
#define PG8_WAIT_V(n) asm volatile("s_waitcnt vmcnt(" #n ")" ::: "memory")
#define PG8_WAIT_VF(n) do { if constexpr (F8) asm volatile("s_waitcnt vmcnt(9)" ::: "memory"); else asm volatile("s_waitcnt vmcnt(" #n ")" ::: "memory"); } while (0)
#define PG8_WAIT_VG(n) do { if (GATHER && has_next && t == 0) { if constexpr (F8) asm volatile("s_waitcnt vmcnt(13)" ::: "memory"); else asm volatile("s_waitcnt vmcnt(12)" ::: "memory"); } else PG8_WAIT_VF(n); } while (0)
#define PG8_WAIT_L(n) asm volatile("s_waitcnt lgkmcnt(" #n ")" ::: "memory")
#define PG8_BAR __builtin_amdgcn_s_barrier()
#define PG8_SCHED __builtin_amdgcn_sched_barrier(0)
    const unsigned sc_lane = (unsigned)(wc * 64 + lane) * 8u;
    unsigned scx = 0x7F7F7F7Fu, scy = 0x7F7F7F7Fu;
    Unit cur, nxt; int ui = 0;
    if (!S.next(0, cur)) return;
    f32x4 acc[2][2][4][2];
    v2u bnx[2][2];
#pragma unroll
    for (int b = 0; b < 2; ++b)
#pragma unroll
        for (int n = 0; n < 2; ++n) bnx[b][n] = (v2u){0u, 0u};
#pragma unroll
    for (int a = 0; a < 2; ++a)
#pragma unroll
        for (int b = 0; b < 2; ++b)
#pragma unroll
            for (int m = 0; m < 4; ++m)
#pragma unroll
                for (int n = 0; n < 2; ++n) acc[a][b][m][n] = (f32x4){bflo(bnx[b][n].x), bfhi(bnx[b][n].x), bflo(bnx[b][n].y), bfhi(bnx[b][n].y)} + (b ? Epi::BIAS1_ADD : 0.f);
    bf16x8 At[4][2], B0[2][2], B1[2][2];
    const char* cA = cur.A; const char* cB = cur.B; const char* cS = cur.S;
    if constexpr (F8) scx = ld_hidden(cS, sc_lane);
    if constexpr (GATHER) { PG8_GRAW(gnxt, cur); asm volatile("s_waitcnt vmcnt(0)" : "+v"(gnxt[0][0]), "+v"(gnxt[0][1]), "+v"(gnxt[1][0]), "+v"(gnxt[1][1]) :: "memory"); PG8_GFIN(gcur, gnxt); }
    PG8_STAGE(PG8_SB(0, 0), cB, voffB); PG8_STAGE(PG8_SB(0, 1), cB + hstepB, voffB); PG8_STAGE_A(PG8_SA(0, 0), cA, 0, gcur); PG8_STAGE_A(PG8_SA(0, 1), cA, 1, gcur);
    if (wr == 1) PG8_BAR;
    PG8_WAIT_V(2); PG8_BAR;
    PG8_STAGE(PG8_SB(1, 0), cB + kstepB, voffB); PG8_STAGE_A(PG8_SA(1, 0), cA + kstep, 0, gcur); PG8_STAGE(PG8_SB(1, 1), cB + hstepB + kstepB, voffB);
    PG8_WAIT_V(6); PG8_BAR;
    if constexpr (Epi::BIAS_INIT) { E.load_bias(cur, wc, fq, bnx);
#pragma unroll
        for (int a = 0; a < 2; ++a)
#pragma unroll
            for (int b = 0; b < 2; ++b)
#pragma unroll
                for (int m = 0; m < 4; ++m)
#pragma unroll
                    for (int n = 0; n < 2; ++n) acc[a][b][m][n] = (f32x4){bflo(bnx[b][n].x), bfhi(bnx[b][n].x), bflo(bnx[b][n].y), bfhi(bnx[b][n].y)} + (b ? Epi::BIAS1_ADD : 0.f); }
    for (;;) {
        const bool has_next = S.next(ui + 1, nxt);
        const char* nA = has_next ? nxt.A : cA; const char* nB = has_next ? nxt.B : cB; const char* nS = has_next ? nxt.S : cS;
        if constexpr (GATHER) { if (has_next) { PG8_GRAW(gnxt, nxt); } }
        unsigned g2[2][2];
#pragma unroll 1
        for (int t = 0; t < nt; t += 2) {
            const bool last = (t == nt - 2);
            const char* a1 = cA + (size_t)(t + 1) * kstep;
            const char* a2 = last ? nA : cA + (size_t)(t + 2) * kstep; const char* b2 = last ? nB : cB + (size_t)(t + 2) * kstepB;
            const char* a3 = a2 + kstep; const char* b3 = b2 + kstepB;
            if constexpr (GATHER) {
                if (last && has_next) { asm volatile("" : "+v"(gnxt[0][0]), "+v"(gnxt[0][1]), "+v"(gnxt[1][0]), "+v"(gnxt[1][1]));
                    PG8_GFIN(g2, gnxt);
                } else {
#pragma unroll
                    for (int h_ = 0; h_ < 2; ++h_)
#pragma unroll
                        for (int i_ = 0; i_ < 2; ++i_) g2[h_][i_] = gcur[h_][i_]; } }
            PG8_LDB(B0, 0, 0); PG8_LDB(B1, 0, 1); PG8_SCHED; PG8_LDA(At, 0, 0); PG8_STAGE_A(PG8_SA(1, 1), a1, 1, gcur);
            if constexpr (F8) scy = ld_hidden(cS + (size_t)(t >> 1) * 2048 + 4, sc_lane);
            PG8_WAIT_VG(8); PG8_WAIT_L(0); PG8_BAR; PG8_MMA(0, 0, At, B0, scx); PG8_MMA(0, 1, At, B1, scx); PG8_BAR; PG8_SCHED;
            PG8_LDA(At, 0, 1); PG8_STAGE(PG8_SB(0, 0), b2, voffB); PG8_STAGE(PG8_SB(0, 1), b2 + hstepB, voffB); PG8_STAGE_A(PG8_SA(0, 0), a2, 0, g2);
            PG8_WAIT_VG(8); PG8_WAIT_L(0); PG8_BAR; if (!cur.half) { PG8_MMA(1, 0, At, B0, scx); PG8_MMA(1, 1, At, B1, scx); } PG8_BAR; PG8_SCHED;
            PG8_LDB(B0, 1, 0); PG8_LDB(B1, 1, 1); PG8_SCHED; PG8_LDA(At, 1, 0); PG8_STAGE_A(PG8_SA(0, 1), a2, 1, g2);
            if constexpr (F8) { const char* sp = last ? nS : cS + (size_t)((t >> 1) + 1) * 2048; scx = ld_hidden(sp, sc_lane); }
            PG8_WAIT_VF(8); PG8_WAIT_L(0); PG8_BAR; PG8_MMA(0, 0, At, B0, scy); PG8_MMA(0, 1, At, B1, scy); PG8_BAR; PG8_SCHED;
            PG8_LDA(At, 1, 1); PG8_STAGE(PG8_SB(1, 0), b3, voffB); PG8_STAGE(PG8_SB(1, 1), b3 + hstepB, voffB); PG8_STAGE_A(PG8_SA(1, 0), a3, 0, g2);
            PG8_WAIT_VF(8); PG8_WAIT_L(0); PG8_BAR; if (!cur.half) { PG8_MMA(1, 0, At, B0, scy); PG8_MMA(1, 1, At, B1, scy); } PG8_BAR; PG8_SCHED;
        }
        if constexpr (F8) asm volatile("s_nop 15\n\ts_nop 15" ::: "memory");
        if (wr == 0) PG8_BAR;
        if constexpr (Epi::BIAS_INIT) { if (has_next) E.load_bias(nxt, wc, fq, bnx); }
        E(acc, cur, wr, wc, fr, fq);
        if (!has_next) break;
#pragma unroll
        for (int a = 0; a < 2; ++a)
#pragma unroll
            for (int b = 0; b < 2; ++b)
#pragma unroll
                for (int m = 0; m < 4; ++m)
#pragma unroll
                    for (int n = 0; n < 2; ++n) acc[a][b][m][n] = (f32x4){bflo(bnx[b][n].x), bfhi(bnx[b][n].x), bflo(bnx[b][n].y), bfhi(bnx[b][n].y)} + (b ? Epi::BIAS1_ADD : 0.f);
        cur = nxt; cA = nA; cB = nB; cS = nS; ++ui;
        if constexpr (GATHER) {
#pragma unroll
            for (int h_ = 0; h_ < 2; ++h_)
#pragma unroll
                for (int i_ = 0; i_ < 2; ++i_) gcur[h_][i_] = g2[h_][i_]; }
        if (wr == 1) PG8_BAR;
    }
    PG8_WAIT_V(0);
    PG8_BAR;
#undef PG8_SA
#undef PG8_SB
#undef PG8_STAGE
#undef PG8_STAGE_A
#undef PG8_GRAW
#undef PG8_GFIN
#undef PG8_LDA
#undef PG8_LDB
#undef PG8_MMA
#undef PG8_CAT
#undef PG8_WAIT_V
#undef PG8_WAIT_VF
#undef PG8_WAIT_VG
#undef PG8_WAIT_L
#undef PG8_BAR
#undef PG8_SCHED
}
}
struct Args { const float* in[38]; float* out; unsigned char* ws; int ph_lo, ph_hi, rep, pad; };
typedef const __attribute__((address_space(4))) Args* CArgsP;
DI CArgsP kargs() { CArgsP p = (CArgsP)__builtin_amdgcn_kernarg_segment_ptr(); asm volatile("" : "+s"(p)); return p; }
struct Frame {
    LAS unsigned char* lds;
    volatile LAS unsigned* MISC;
    gu32* ctl;
    unsigned char* ws;
    int tid, lane, wave, G, vcu;
};
DI unsigned char* WSP(const Frame& F) { unsigned char* p = F.ws; asm volatile("" : "+s"(p)); return p; }
DI Frame refresh(const Frame& G) { Frame F = G; int t = G.wave * 64 + lane_id(); asm volatile("" : "+v"(t)); F.tid = t; F.lane = t & 63; F.wave = G.wave;
    unsigned char* w = G.ws; asm volatile("" : "+s"(w)); F.ws = w; return F; }
enum { I_X = 0, I_C, I_CTX, I_CCTX, I_ADAW, I_ADAB, I_N1G, I_N2G, I_EVWIN, I_EVWOUT, I_LAMRE, I_LAMIM, I_LOGSTEP, I_BRE, I_BIM, I_CRE, I_CIM, I_S5D, I_GLUW, I_GLUB,
       I_ODWIN, I_ODWOUT, I_SGULNG, I_SGULNB, I_SGUW, I_SGUB, I_LQ1, I_LK1, I_LQ2, I_LK2, I_SUBLN, I_RW, I_RB, I_W1, I_B1, I_W2, I_B2, I_FING };

DI void transpose_tile(const float* W, int N, int k0, int n0, bf16* WT, int Kd, int dst_row0, LAS float* scr, int lane) {
    f32x4 v[16];
#pragma unroll
    for (int i = 0; i < 16; ++i) v[i] = *(const GAS f32x4*)(W + (size_t)(k0 + 4 * i + (lane >> 4)) * N + n0 + 4 * (lane & 15));
#pragma unroll
    for (int i = 0; i < 16; ++i) { LAS float* d = scr + (4 * i + (lane >> 4)) * 65 + 4 * (lane & 15); d[0] = v[i].x; d[1] = v[i].y; d[2] = v[i].z; d[3] = v[i].w; }
    LDS_WAIT(); asm volatile("" ::: "memory");
    const int c = lane & 7;
#pragma unroll
    for (int j = 0; j < 8; ++j) { const int n = (lane >> 3) + 8 * j; const LAS float* s = scr + (8 * c) * 65 + n;
        v4u o; o.x = pk2(s[0], s[65]); o.y = pk2(s[130], s[195]); o.z = pk2(s[260], s[325]); o.w = pk2(s[390], s[455]);
        *(GAS v4u*)(WT + (size_t)(dst_row0 + n) * Kd + k0 + 8 * c) = o; }
    LDS_WAIT(); asm volatile("" ::: "memory");
}

DI void transpose_tile_f8(const float* W, int N, int k0, int n0, unsigned char* dst, unsigned char* sc, int kb, int r0, LAS float* scr, int lane) {
    f32x4 v[16];
#pragma unroll
    for (int i = 0; i < 16; ++i) v[i] = *(const GAS f32x4*)(W + (size_t)(k0 + 4 * i + (lane >> 4)) * N + n0 + 4 * (lane & 15));
#pragma unroll
    for (int i = 0; i < 16; ++i) { LAS float* d = scr + (4 * i + (lane >> 4)) * 65 + 4 * (lane & 15); d[0] = v[i].x; d[1] = v[i].y; d[2] = v[i].z; d[3] = v[i].w; }
    LDS_WAIT(); asm volatile("" ::: "memory");
    const int c = lane & 7, T = kb >> 1, blk = 2 * (kb & 1) + (c >> 2);
#pragma unroll
    for (int j = 0; j < 8; ++j) { const int n = (lane >> 3) + 8 * j; const LAS float* s = scr + (8 * c) * 65 + n;
        float x[8];
#pragma unroll
        for (int e = 0; e < 8; ++e) x[e] = s[65 * e];
        float am = fmaxf(fmaxf(fmaxf(fabsf(x[0]), fabsf(x[1])), fmaxf(fabsf(x[2]), fabsf(x[3]))), fmaxf(fmaxf(fabsf(x[4]), fabsf(x[5])), fmaxf(fabsf(x[6]), fabsf(x[7]))));
        am = fmaxf(am, xor_lane<1>(am, lane)); am = fmaxf(am, xor_lane<2>(am, lane));
        const unsigned ab = __builtin_bit_cast(unsigned, am);
        int sb = (int)(ab >> 23) - 8 + ((ab & 0x7FFFFFu) > 0x600000u ? 1 : 0);
        sb = sb < 1 ? 1 : (sb > 253 ? 253 : sb);
        const float mul = __builtin_bit_cast(float, (unsigned)(254 - sb) << 23);
        v2u o; o.x = pk4_fp8(x[0] * mul, x[1] * mul, x[2] * mul, x[3] * mul); o.y = pk4_fp8(x[4] * mul, x[5] * mul, x[6] * mul, x[7] * mul);
        *(GAS v2u*)(dst + (size_t)n * 128 + 64 * (kb & 1) + 8 * c) = o;
        if ((c & 3) == 0) { const int r = r0 + n, r32 = r & 31;
            sc[(size_t)((((T >> 1) * 4 + ((r >> 5) & 3)) * 64 + blk * 16 + 4 * (r32 >> 3) + (r32 & 3)) * 8 + (T & 1) * 4 + (r >> 7) * 2 + ((r32 >> 2) & 1))] = (unsigned char)sb; }
    }
    LDS_WAIT(); asm volatile("" ::: "memory");
}

DI void mod_item(Frame& F, CArgsP a, int item) {
    unsigned char* const ws = WSP(F);
    LAS float* sv = (LAS float*)F.lds;
    LAS float* part = sv + 5 * 1024;
    const int layer = item / 96, cg = item % 96, col = cg * 64 + F.lane;
    for (int i = F.tid; i < 5 * 1024; i += 512) { const int v = i >> 10, k = i & 1023; const float x = v < 4 ? a->in[I_C][v * 1024 + k] : a->in[I_CCTX][k]; sv[i] = silu_(x); }
    __syncthreads();
    const float* W = a->in[I_ADAW] + (size_t)layer * 1024 * 6144 + col;
    float acc[5] = {0.f, 0.f, 0.f, 0.f, 0.f};
    const int kb = F.wave * 128;
#pragma unroll 32
    for (int k = 0; k < 128; ++k) { const float w = W[(size_t)(kb + k) * 6144];
#pragma unroll
        for (int v = 0; v < 5; ++v) acc[v] += sv[v * 1024 + kb + k] * w; }
#pragma unroll
    for (int v = 0; v < 5; ++v) part[(F.wave * 5 + v) * 64 + F.lane] = acc[v];
    __syncthreads();
    if (F.tid < 320) { const int v = F.tid >> 6, l = F.tid & 63; float s = 0.f;
#pragma unroll
        for (int w = 0; w < 8; ++w) s += part[(w * 5 + v) * 64 + l];
        const int c2 = cg * 64 + l;
        ((float*)(ws + WS_MOD))[(size_t)(layer * 5 + v) * 6144 + c2] = s + a->in[I_ADAB][layer * 6144 + c2]; }
    __syncthreads();
}

DI void s5mat_item(Frame& F, CArgsP a, int item) {
    unsigned char* const ws = WSP(F);
    const int j = item / 48, g = item % 48;
    LAS float* apw = (LAS float*)F.lds;
    LAS float* bb = apw + 2 * 64 * 33 * 2;
    LAS float* cm = bb + 2 * 64 * 16 * 2;
    LAS float* kk = cm + 2 * 16 * 64 * 2;
    LAS float* dd = kk + 2 * 32 * 256;
    for (int i = F.tid; i < 2 * 64; i += 512) { const int dir = i >> 6, n = i & 63;
        const size_t p = ((size_t)(j * 2 + dir) * 48 + g) * 64 + n;
        const float lre = a->in[I_LAMRE][p], lim = a->in[I_LAMIM][p], step = expf(a->in[I_LOGSTEP][(j * 2 + dir) * 48 + g]);
        for (int tau = 0; tau <= 32; ++tau) { const float mag = expf(lre * step * tau), ang = lim * step * tau; apw[(i * 33 + tau) * 2] = mag * cosf(ang); apw[(i * 33 + tau) * 2 + 1] = mag * sinf(ang); }
        const float ar = apw[(i * 33 + 1) * 2] - 1.f, ai = apw[(i * 33 + 1) * 2 + 1];
        const float den = 1.f / (lre * lre + lim * lim), qr = (ar * lre + ai * lim) * den, qi = (ai * lre - ar * lim) * den;
        for (int c = 0; c < 16; ++c) { const float br = a->in[I_BRE][p * 16 + c], bi = a->in[I_BIM][p * 16 + c]; bb[(i * 16 + c) * 2] = qr * br - qi * bi; bb[(i * 16 + c) * 2 + 1] = qr * bi + qi * br; }
        ((float*)(ws + WS_APT))[p * 2] = apw[(i * 33 + 32) * 2]; ((float*)(ws + WS_APT))[p * 2 + 1] = apw[(i * 33 + 32) * 2 + 1];
    }
    for (int i = F.tid; i < 2 * 16 * 64; i += 512) { const int dir = i >> 10, c = (i >> 6) & 15, n = i & 63; const size_t p = (((size_t)(j * 2 + dir) * 48 + g) * 16 + c) * 64 + n;
        cm[i * 2] = a->in[I_CRE][p]; cm[i * 2 + 1] = a->in[I_CIM][p]; }
    if (F.tid < 16) dd[F.tid] = a->in[I_S5D][(j * 48 + g) * 16 + F.tid];
    __syncthreads();
    for (int i = F.tid; i < 2 * 32 * 16; i += 512) { const int dir = i >> 9, tau = (i >> 4) & 31, c = i & 15;
        float s[16];
#pragma unroll
        for (int q = 0; q < 16; ++q) s[q] = 0.f;
#pragma unroll 2
        for (int n = 0; n < 64; ++n) { const f32x2 cv = *(const LAS f32x2*)(cm + ((dir * 16 + c) * 64 + n) * 2), av = *(const LAS f32x2*)(apw + ((dir * 64 + n) * 33 + tau) * 2);
            const float gr = cv.x * av.x - cv.y * av.y, gi = cv.x * av.y + cv.y * av.x;
            const LAS f32x4* bp = (const LAS f32x4*)(bb + (dir * 64 + n) * 32);
#pragma unroll
            for (int q = 0; q < 8; ++q) { const f32x4 b = bp[q]; s[2 * q] += gr * b.x - gi * b.y; s[2 * q + 1] += gr * b.z - gi * b.w; } }
#pragma unroll
        for (int q = 0; q < 16; ++q) kk[((dir * 32 + tau) * 16 + c) * 16 + q] = s[q]; }
    __syncthreads();
    bf16* Wc = (bf16*)(ws + WS_WC) + (size_t)(j * 48 + g) * 512 * 768;
    for (int i = F.tid; i < 512 * 768 / 2; i += 512) { const int row = i / 384, k0 = (i % 384) * 2; const int t = row >> 4, c = row & 15; float v[2];
#pragma unroll
        for (int e = 0; e < 2; ++e) { const int k = k0 + e; float x;
            if (k < 512) { const int s = k >> 4, c2 = k & 15; x = 0.f;
                if (s <= t) x += kk[((0 * 32 + (t - s)) * 16 + c) * 16 + c2];
                if (s >= t) x += kk[((1 * 32 + (s - t)) * 16 + c) * 16 + c2];
                if (s == t && c == c2) x += dd[c];
            } else { const int q = k - 512, dir = q >> 7, n = (q >> 1) & 63, ri = q & 1; const int tau = dir ? (32 - t) : (t + 1);
                const float cr = cm[((dir * 16 + c) * 64 + n) * 2], ci = cm[((dir * 16 + c) * 64 + n) * 2 + 1];
                const float ar = apw[((dir * 64 + n) * 33 + tau) * 2], ai = apw[((dir * 64 + n) * 33 + tau) * 2 + 1];
                x = ri ? -(cr * ai + ci * ar) : (cr * ar - ci * ai); }
            v[e] = x; }
        *(GAS unsigned*)(Wc + (size_t)row * 768 + k0) = pk2(v[0], v[1]); }
    bf16* Eo = (bf16*)(ws + WS_EOUT) + (size_t)(j * 48 + g) * 256 * 512;
    for (int i = F.tid; i < 256 * 512 / 2; i += 512) { const int row = i >> 8, k0 = (i & 255) * 2; const int dir = row >> 7, n = (row >> 1) & 63, ri = row & 1; float v[2];
#pragma unroll
        for (int e = 0; e < 2; ++e) { const int k = k0 + e, t = k >> 4, c = k & 15; const int tau = dir ? t : (31 - t);
            const float ar = apw[((dir * 64 + n) * 33 + tau) * 2], ai = apw[((dir * 64 + n) * 33 + tau) * 2 + 1];
            const float br = bb[((dir * 64 + n) * 16 + c) * 2], bi = bb[((dir * 64 + n) * 16 + c) * 2 + 1];
            v[e] = ri ? (ar * bi + ai * br) : (ar * br - ai * bi); }
        *(GAS unsigned*)(Eo + (size_t)row * 512 + k0) = pk2(v[0], v[1]); }
    __syncthreads();
}

DI void wpq_item(Frame& F, CArgsP a, int item, LAS float* scr) {
    unsigned char* const ws = WSP(F);
    const int j = item >> 6, g = (item >> 4) & 3, k0 = (item & 15) * 64;
    const float* W = a->in[I_EVWIN] + (size_t)j * 1024 * 1024;
#pragma unroll 4
    for (int i = 0; i < 64; ++i) scr[i * 65 + F.lane] = W[(size_t)(k0 + i) * 1024 + g * 64 + F.lane];
    LDS_WAIT(); asm volatile("" ::: "memory");
    bf16* O = (bf16*)(ws + WS_WEV_PQ) + (size_t)j * 512 * 1024;
    const LAS float* row = scr + F.lane * 65; const LAS float* trig = (const LAS float*)(F.lds + 133120);
    for (int m = 0; m < 64; ++m) { float p = 0.f, q = 0.f;
#pragma unroll 8
        for (int c = 0; c < 64; ++c) { const int r = (m * c) & 63; p += row[c] * trig[r]; q += row[c] * trig[64 + r]; }
        O[(size_t)(g * 64 + m) * 1024 + k0 + F.lane] = (bf16)f2bf(p); O[(size_t)(256 + g * 64 + m) * 1024 + k0 + F.lane] = (bf16)f2bf(q); }
    LDS_WAIT(); asm volatile("" ::: "memory");
}

DI void prologue0(Frame& F, CArgsP a) {
    unsigned char* const ws = WSP(F);
    for (int it = F.vcu; it < 384 + 96; it += F.G) { if (it < 384) mod_item(F, a, it); else s5mat_item(F, a, it - 384); }
    if (F.tid < 64) { LAS float* trig = (LAS float*)(F.lds + 133120); trig[F.tid] = cospif((float)F.tid * (1.f / 32.f)); trig[64 + F.tid] = sinpif((float)F.tid * (1.f / 32.f)); }
    __syncthreads();
    const int gw = F.vcu * 8 + F.wave, NGW = F.G * 8;
    LAS float* scr = (LAS float*)(F.lds + F.wave * 16640);
    for (int i = gw * 64 + F.lane; i < 128 * 16; i += NGW * 64) { const int pos = i >> 4, f = i & 15; const float inv = powf(10000.f, -(float)(2 * f) / 32.f), ang = (float)pos * inv;
        ((float*)(ws + WS_ROPE))[i * 2] = cosf(ang); ((float*)(ws + WS_ROPE))[i * 2 + 1] = sinf(ang); }
    for (int i = gw * 64 + F.lane; i < 4096; i += NGW * 64) { ((float*)(ws + WS_TW))[i * 2] = cospif((float)i * (1.f / 4096.f)); ((float*)(ws + WS_TW))[i * 2 + 1] = -sinpif((float)i * (1.f / 4096.f)); }
    for (int i = gw * 64 + F.lane; i < 4 * 32768; i += NGW * 64) { const int layer = i >> 15, q = i & 32767, k = q >> 5, e = q & 31; const float v = a->in[I_RW][i];
        const unsigned hi = f2bf(v), lo = f2bf(v - bf2f(hi)); unsigned char* img = ws + WS_RIMG + (size_t)layer * (64 * RT_PITCH);
        *(bf16*)(img + e * RT_PITCH + k * 2) = (bf16)hi; *(bf16*)(img + (32 + e) * RT_PITCH + k * 2) = (bf16)lo; }
    for (int i = gw * 64 + F.lane; i < (4 * 32 * 2048 + 4 * 32 * 1024 + 2 * 768) / 4; i += NGW * 64) { const float* src; bf16* dst; int o = i * 4;
        if (o < 4 * 32 * 2048) { src = a->in[I_B1] + o; dst = (bf16*)(ws + WS_B1H) + o; } else { o -= 4 * 32 * 2048;
            if (o < 4 * 32 * 1024) { src = a->in[I_B2] + o; dst = (bf16*)(ws + WS_B1H + 512 * 1024) + o; } else { o -= 4 * 32 * 1024; src = a->in[I_GLUB] + o; dst = (bf16*)(ws + WS_B1H + 768 * 1024) + o; } }
        const f32x4 v = *(const GAS f32x4*)src; v2u w; w.x = pk2(v.x, v.y); w.y = pk2(v.z, v.w); *(GAS v2u*)dst = w; }
    if (gw < 2) { const int jl = gw, layer = 2 * jl + 1; const float d1 = wave_sum(a->in[I_LQ1][jl * 64 + F.lane] * a->in[I_LK1][jl * 64 + F.lane]), d2 = wave_sum(a->in[I_LQ2][jl * 64 + F.lane] * a->in[I_LK2][jl * 64 + F.lane]);
        const float lam_init = 0.8f - 0.6f * expf(-0.3f * (float)layer);
        if (F.lane == 0) { ((float*)(ws + WS_CB))[jl * 2] = expf(d1) - expf(d2) + lam_init; ((float*)(ws + WS_CB))[jl * 2 + 1] = lam_init; } }
    for (int i = gw * 64 + F.lane; i < 2 * 4 * 128 * 128 / 4; i += NGW * 64) { const f32x4 v = ((const GAS f32x4*)a->in[I_SGUW])[i]; v2u o; o.x = pk2(v.x, v.y); o.y = pk2(v.z, v.w); ((GAS v2u*)(ws + WS_SGUW))[i] = o; }
    constexpr int T_EVS5 = 2 * 16 * 12, T_EVOUT = 2 * 16 * 16, T_GLU = 2 * 12 * 12, T_ODIN = 2 * 16 * 40, T_ODOUT = 2 * 16 * 16, T_W1 = 128 * 16 * 32, T_W2 = 128 * 16 * 16, T_WPQ = 128;
    constexpr int T_ALL = T_EVS5 + T_EVOUT + T_GLU + T_ODIN + T_ODOUT + T_W1 + T_W2 + T_WPQ;
    for (int it = gw; it < T_ALL; it += NGW) {
        int r = it;
        if (r < T_WPQ) { wpq_item(F, a, r, scr); continue; } r -= T_WPQ;
        if (r < T_EVS5) { const int j = r / 192, q = r % 192, kb = q / 12, nb = q % 12;
            transpose_tile(a->in[I_EVWIN] + (size_t)j * 1048576, 1024, kb * 64, 256 + nb * 64, (bf16*)(ws + WS_WEV_S5) + (size_t)j * 768 * 1024, 1024, nb * 64, scr, F.lane); continue; } r -= T_EVS5;
        if (r < T_EVOUT) { const int j = r / 256, q = r % 256, kb = q / 16, nb = q % 16;
            { const int drow = nb * 64; transpose_tile_f8(a->in[I_EVWOUT] + (size_t)j * 1048576, 1024, kb * 64, nb * 64, ws + WS_WEV_OUT + (size_t)j * 1048576 + ((size_t)((drow >> 8) * 8 + (kb >> 1)) * 256 + (drow & 255)) * 128, ws + WS_SC3 + (size_t)j * 32768 + (size_t)(drow >> 8) * 8192, kb, drow & 255, scr, F.lane); } continue; } r -= T_EVOUT;
        if (r < T_GLU) { const int j = r / 144, q = r % 144, kb = q / 12, nb = q % 12;
            transpose_tile(a->in[I_GLUW] + (size_t)j * 768 * 768, 768, kb * 64, nb * 64, (bf16*)(ws + WS_GLUW) + (size_t)j * 768 * 768, 768, nb * 64, scr, F.lane); continue; } r -= T_GLU;
        if (r < T_ODIN) { const int j = r / 640, q = r % 640, kb = q / 40, nb = q % 40;
            transpose_tile(a->in[I_ODWIN] + (size_t)j * 1024 * 2560, 2560, kb * 64, nb * 64, (bf16*)(ws + WS_WOD_IN) + (size_t)j * 2560 * 1024, 1024, nb * 64, scr, F.lane); continue; } r -= T_ODIN;
        if (r < T_ODOUT) { const int j = r / 256, q = r % 256, kb = q / 16, nb = q % 16;
            { const int drow = nb * 64; transpose_tile_f8(a->in[I_ODWOUT] + (size_t)j * 1048576, 1024, kb * 64, nb * 64, ws + WS_WOD_OUT + (size_t)j * 1048576 + ((size_t)((drow >> 8) * 8 + (kb >> 1)) * 256 + (drow & 255)) * 128, ws + WS_SC3 + 65536 + (size_t)j * 32768 + (size_t)(drow >> 8) * 8192, kb, drow & 255, scr, F.lane); } continue; } r -= T_ODOUT;
        if (r < T_W1) { const int le = r / 512, q = r % 512, kb = q / 32, nb = q % 32;
            const int n0 = nb * 64, half = n0 >> 10, nn = n0 & 1023, drow = 256 * (nn >> 7) + 128 * half + (nn & 127);
            transpose_tile_f8(a->in[I_W1] + (size_t)le * 1024 * 2048, 2048, kb * 64, n0, ws + WS_W1T + (size_t)le * 2048 * 1024 + ((size_t)((drow >> 8) * 8 + (kb >> 1)) * 256 + (drow & 255)) * 128, ws + WS_SC1 + (size_t)le * 65536 + (size_t)(drow >> 8) * 8192, kb, drow & 255, scr, F.lane); continue; } r -= T_W1;
        { const int le = r / 256, q = r % 256, kb = q / 16, nb = q % 16; const int drow = nb * 64;
            transpose_tile_f8(a->in[I_W2] + (size_t)le * 1048576, 1024, kb * 64, nb * 64, ws + WS_W2T + (size_t)le * 1048576 + ((size_t)((drow >> 8) * 8 + (kb >> 1)) * 256 + (drow & 255)) * 128, ws + WS_SC2 + (size_t)le * 32768 + (size_t)(drow >> 8) * 8192, kb, drow & 255, scr, F.lane); }
    }
}

DI int mod_row(int row) { return row < NLAT ? (row >> 13) : 4; }

DI void norm_mod_row(const float* src, bf16* hcopy, const float* gvec, const float* shift, const float* scale, bf16* dst, int lane) {
    f32x4 v[4]; float s = 0.f;
#pragma unroll
    for (int j = 0; j < 4; ++j) { v[j] = ((const GAS f32x4*)src)[lane + 64 * j]; s += (v[j].x * v[j].x + v[j].y * v[j].y) + (v[j].z * v[j].z + v[j].w * v[j].w); }
    if (hcopy) {
#pragma unroll
        for (int j = 0; j < 4; ++j) { v2u o; o.x = pk2(v[j].x, v[j].y); o.y = pk2(v[j].z, v[j].w); ((GAS v2u*)hcopy)[lane + 64 * j] = o; } }
    const float rstd = 1.f / sqrtf(wave_sum(s) * (1.f / 1024.f) + EPS);
#pragma unroll
    for (int j = 0; j < 4; ++j) { const f32x4 g = ((const GAS f32x4*)gvec)[lane + 64 * j], sh = ((const GAS f32x4*)shift)[lane + 64 * j], sc = ((const GAS f32x4*)scale)[lane + 64 * j];
        const f32x4 y = v[j] * rstd * g * (sc + 1.f) + sh; v2u o; o.x = pk2(y.x, y.y); o.y = pk2(y.z, y.w); ((GAS v2u*)dst)[lane + 64 * j] = o; }
}

DI void prologue1(Frame& F, CArgsP a) {
    unsigned char* const ws = WSP(F);
    const int gw = F.vcu * 8 + F.wave, NGW = F.G * 8;
    const float* MOD = (const float*)(ws + WS_MOD);
    for (int i = gw * 64 + F.lane; i < 4 * 5 * 1024; i += NGW * 64) { const int lm = i >> 10, k = i & 1023, l = lm / 5;
        ((float*)(ws + WS_AM))[i] = a->in[I_N2G][l * 1024 + k] * (1.f + MOD[(size_t)lm * 6144 + 4 * 1024 + k]); }
#pragma unroll 1
    for (int row = gw; row < NTOK; row += NGW) {
        const float* src = row < NLAT ? a->in[I_X] + (size_t)row * 1024 : a->in[I_CTX] + (size_t)(row - NLAT) * 1024;
        const float* m = MOD + (size_t)(0 * 5 + mod_row(row)) * 6144;
        norm_mod_row(src, (bf16*)(ws + WS_H) + (size_t)row * 1024, a->in[I_N1G], m, m + 1024, (bf16*)(ws + WS_XN) + (size_t)row * 1024, F.lane);
    }
}
struct PlainOrder {
    const char* A; const char* B; size_t atile, btile; int nM, nN, G, c, GN; const char* SC = nullptr; bool split = false;
    DI bool next(int i, pg8::Unit& u) const {
        int L = i * G + c; u.half = 0; u.roff = 0;
        { const int N = nM * nN, F = (N / G) * G, rem = N - F;
          if (split && rem > 0 && 2 * rem <= G && L >= F) { const int h = L - F; if (h >= 2 * rem) return false; L = F + (h >> 1); u.half = 1; u.roff = (h & 1) * 128; }
          else if (L >= N) return false; }
        const int full = nN / GN, per = nM * GN;
        if (L < full * per) { const int p = L / per, r = L - p * per; u.pm = r / GN; u.pn = p * GN + (r - u.pm * GN); }
        else { const int rem = nN - full * GN, r = L - full * per; u.pm = r / rem; u.pn = full * GN + (r - u.pm * rem); }
        u.g = 0; u.aux = 0; u.rowidx = nullptr; u.nvalid = 0; u.S = SC + (size_t)u.pn * 8192;
        u.A = A + (size_t)u.pm * atile + (size_t)u.roff * (atile >> 8); u.B = B + (size_t)u.pn * btile; return true;
    }
};
struct GroupOrder {
    const char* A; const char* B; size_t atile, btile, agroup, bgroup; int nM, nN, nG, G, c;
    DI bool next(int i, pg8::Unit& u) const {
        const long L = (long)i * G + c; const int per = nM * nN; if (L >= (long)per * nG) return false;
        u.g = (int)(L / per); const int r = (int)(L % per); u.pn = r / nM; u.pm = r % nM; u.aux = 0; u.rowidx = nullptr; u.nvalid = 0; u.S = nullptr; u.half = 0; u.roff = 0;
        u.A = A + (size_t)u.g * agroup + (size_t)u.pm * atile; u.B = B + (size_t)u.g * bgroup + (size_t)u.pn * btile; return true;
    }
};
struct MoeOrder {
    const char* A; const char* B; size_t bexp, btile; int nN, G, c; const LAS int* tab; const int* inv; bool gather; const char* SC; size_t sexp;
    DI bool next(int i, pg8::Unit& u) const {
        int L = i * G + c; int hf = 0, ro = 0;
        { const int N = tab[33 + 32], F = (N / G) * G, rem = N - F;
          if (rem > 0 && 2 * rem <= G && L >= F) { const int h = L - F; if (h >= 2 * rem) return false; L = F + (h >> 1); hf = 1; ro = (h & 1) * 128; }
          else if (L >= N) return false; }
        int e = 0;
#pragma unroll 1
        for (int k = 16; k >= 1; k >>= 1) if (tab[33 + e + k] <= L) e += k;
        const int r = L - tab[33 + e], mt = tab[66 + e], per = mt * 4, pnl = r / per, r2 = r - pnl * per;
        u.g = e; u.pm = r2 >> 2; u.pn = pnl * 4 + (r2 & 3); u.aux = tab[e] + u.pm * 256; u.half = hf; u.roff = ro;
        u.rowidx = inv + (size_t)e * NTOK + u.pm * 256; u.nvalid = tab[98 + e] - u.pm * 256;
        u.A = gather ? A : A + (size_t)(u.aux + ro) * 1024;
        u.B = B + (size_t)e * bexp + (size_t)u.pn * btile; u.S = SC + (size_t)e * sexp + (size_t)u.pn * 8192; return true;
    }
};

typedef f32x4 AccT[2][2][4][2];
DI v2u pkb4(f32x4 v) { v2u r; r.x = cvt_pk_bf16(v.x, v.y); r.y = cvt_pk_bf16(v.z, v.w); return r; }
template <class Fn> DI void epi_loop_perm(const AccT& acc, int wr, int wc, int fr, int fq, Fn fn, int half = 0, int roff = 0) {
#pragma unroll
    for (int ai = 0; ai < 2; ++ai) { if (ai == 1 && half) break;
#pragma unroll
        for (int m = 0; m < 4; ++m) { const int r = roff + ai * 128 + wr * 64 + m * 16 + fr;
#pragma unroll
            for (int bj = 0; bj < 2; ++bj) fn(r, bj * 128 + wc * 32 + 8 * fq, acc[ai][bj][m][0], acc[ai][bj][m][1]); } }
}
DI v4u pack8(const f32x4& a, const f32x4& b) { v4u w; w.x = cvt_pk_bf16(a.x, a.y); w.y = cvt_pk_bf16(a.z, a.w); w.z = cvt_pk_bf16(b.x, b.y); w.w = cvt_pk_bf16(b.z, b.w); return w; }

struct EpiUG { static constexpr bool PERM = true; static constexpr bool BIAS_INIT = false; static constexpr float BIAS1_ADD = 0.f; bf16* UG;
    DI void operator()(const AccT& acc, const pg8::Unit& u, int wr, int wc, int fr, int fq) const {
        epi_loop_perm(acc, wr, wc, fr, fq, [&](int r, int c0, const f32x4& v0, const f32x4& v1) { const int row = u.pm * 256 + r, col = u.pn * 256 + c0;
            *(GAS v4u*)(UG + ((size_t)(col >> 4) * S5ROWS + (row >> 5)) * S5K + (row & 31) * 16 + (col & 15)) = pack8(v0, v1); });
    } };
struct EpiPQt { static constexpr bool PERM = true; static constexpr bool BIAS_INIT = false; static constexpr float BIAS1_ADD = 0.f; bf16* O;
    DI void operator()(const AccT& acc, const pg8::Unit& u, int wr, int wc, int fr, int fq) const {
        epi_loop_perm(acc, wr, wc, fr, fq, [&](int r, int c0, const f32x4& v0, const f32x4& v1) { const int row = u.pm * 256 + r, col = u.pn * 256 + c0; *(GAS v4u*)(O + (size_t)row * NTOK + col) = pack8(v0, v1); }, u.half, u.roff);
    } };
struct EpiVT { static constexpr bool PERM = true; static constexpr bool BIAS_INIT = false; static constexpr float BIAS1_ADD = 0.f; bf16* VT;
    DI void operator()(const AccT& acc, const pg8::Unit& u, int wr, int wc, int fr, int fq) const {
        const int tok0 = u.pn * 256; int b, kp0; if (tok0 < NLAT) { b = tok0 >> 13; kp0 = CTXL + (tok0 & 8191); } else { b = (tok0 - NLAT) >> 8; kp0 = 0; }
        epi_loop_perm(acc, wr, wc, fr, fq, [&](int r, int c0, const f32x4& v0, const f32x4& v1) { const int row = u.pm * 256 + r; *(GAS v4u*)(VT + ((size_t)b * 512 + row) * KV_LEN + kp0 + c0) = pack8(v0, v1); }, u.half, u.roff);
    } };
struct EpiSloc { static constexpr bool PERM = false; static constexpr bool BIAS_INIT = false; static constexpr float BIAS1_ADD = 0.f; float* S;
    DI void operator()(const AccT& acc, const pg8::Unit& u, int wr, int wc, int fr, int fq) const {
#pragma unroll
        for (int ai = 0; ai < 2; ++ai)
#pragma unroll
            for (int m = 0; m < 4; ++m) { const int r = u.pm * 256 + ai * 128 + wr * 64 + m * 16 + fr; float* rp = S + ((size_t)u.g * S5ROWS + r) * 256 + wc * 32 + 4 * fq;
#pragma unroll
                for (int bj = 0; bj < 2; ++bj)
#pragma unroll
                    for (int n = 0; n < 2; ++n) *(GAS f32x4*)(rp + bj * 128 + n * 16) = acc[ai][bj][m][n]; }
    } };
struct EpiS5Out { static constexpr bool PERM = true; static constexpr bool BIAS_INIT = false; static constexpr float BIAS1_ADD = 0.f; bf16* YB;
    DI void operator()(const AccT& acc, const pg8::Unit& u, int wr, int wc, int fr, int fq) const {
        epi_loop_perm(acc, wr, wc, fr, fq, [&](int r, int c0, const f32x4& v0, const f32x4& v1) { const int row = u.pm * 256 + r, col = u.pn * 256 + c0;
            if (row < 1056) { f32x4 a, b;
#pragma unroll
                for (int i = 0; i < 4; ++i) { a[i] = gelu_tanh(v0[i]); b[i] = gelu_tanh(v1[i]); }
                *(GAS v4u*)(YB + ((size_t)row * 32 + (col >> 4)) * 768 + u.g * 16 + (col & 15)) = pack8(a, b); } });
    } };
struct EpiGLU { static constexpr bool PERM = true; static constexpr bool BIAS_INIT = true; static constexpr float BIAS1_ADD = 0.f; const bf16* YB; const bf16* bias; bf16* CAT;
    DI void load_bias(const pg8::Unit& u, int wc, int fq, v2u (&b)[2][2]) const { const bf16* bp = bias + u.pn * 256 + wc * 32 + 8 * fq;
#pragma unroll
        for (int bj = 0; bj < 2; ++bj) { b[bj][0] = *(const GAS v2u*)(bp + bj * 128); b[bj][1] = *(const GAS v2u*)(bp + bj * 128 + 4); } }
    DI void operator()(const AccT& acc, const pg8::Unit& u, int wr, int wc, int fr, int fq) const {
        epi_loop_perm(acc, wr, wc, fr, fq, [&](int r, int c0, const f32x4& v0, const f32x4& v1) { const int row = u.pm * 256 + r, col = u.pn * 256 + c0;
            const v4u yw = *(const GAS v4u*)(YB + (size_t)row * 768 + col);
            f32x4 a, b; const unsigned ys[4] = {yw.x, yw.y, yw.z, yw.w};
#pragma unroll
            for (int i = 0; i < 4; ++i) { const float y0 = (i & 1) ? bfhi(ys[i >> 1]) : bflo(ys[i >> 1]); const float y1 = (i & 1) ? bfhi(ys[2 + (i >> 1)]) : bflo(ys[2 + (i >> 1)]);
                a[i] = y0 * sigmoidf_(v0[i]); b[i] = y1 * sigmoidf_(v1[i]); }
            v2u o; o.x = pk4_fp8(a.x, a.y, a.z, a.w); o.y = pk4_fp8(b.x, b.y, b.z, b.w); *(GAS v2u*)((unsigned char*)CAT + (size_t)row * 1024 + 256 + col) = o; });
    } };
struct EpiResid { static constexpr bool PERM = true; static constexpr bool BIAS_INIT = false; static constexpr float BIAS1_ADD = 0.f; bf16* H; const float* gate;
    DI void operator()(const AccT& acc, const pg8::Unit& u, int wr, int wc, int fr, int fq) const {
        const float* gp = gate + (size_t)mod_row(u.pm * 256) * 6144 + u.pn * 256 + wc * 32 + 8 * fq;
        f32x4 gv[2][2];
#pragma unroll
        for (int bj = 0; bj < 2; ++bj) { gv[bj][0] = *(const GAS f32x4*)(gp + bj * 128); gv[bj][1] = *(const GAS f32x4*)(gp + bj * 128 + 4); }
#pragma unroll
        for (int ai = 0; ai < 2; ++ai) { if (ai == 1 && u.half) break;
#pragma unroll
            for (int m = 0; m < 4; ++m) { const int r = u.pm * 256 + u.roff + ai * 128 + wr * 64 + m * 16 + fr; bf16* rp = H + (size_t)r * 1024 + u.pn * 256 + wc * 32 + 8 * fq;
#pragma unroll
                for (int bj = 0; bj < 2; ++bj) { const v4u hw = *(const GAS v4u*)(rp + bj * 128);
                    const f32x4 h0 = {bflo(hw.x), bfhi(hw.x), bflo(hw.y), bfhi(hw.y)}, h1 = {bflo(hw.z), bfhi(hw.z), bflo(hw.w), bfhi(hw.w)};
                    *(GAS v4u*)(rp + bj * 128) = pack8(h0 + gv[bj][0] * acc[ai][bj][m][0], h1 + gv[bj][1] * acc[ai][bj][m][1]); } } }
    } };
struct EpiOddIn { static constexpr bool PERM = false; static constexpr bool BIAS_INIT = false; static constexpr float BIAS1_ADD = 0.f; bf16 *U, *VS, *Q, *KALL; const float* rope; float qscale;
    DI void operator()(const AccT& acc, const pg8::Unit& u, int wr, int wc, int fr, int fq) const {
        const int sect = u.pn >> 1;
        const int colbase = (u.pn & 1) * 256;
        const int row00 = u.pm * 256 + u.roff; const bool lat = row00 < NLAT;
#pragma unroll
        for (int ai = 0; ai < 2; ++ai) { if (ai == 1 && u.half) break;
#pragma unroll
            for (int m = 0; m < 4; ++m) { const int row = row00 + ai * 128 + wr * 64 + m * 16 + fr; asm volatile("" ::: "memory");
#pragma unroll
                for (int bj = 0; bj < 2; ++bj) { f32x4 x1 = acc[ai][bj][m][0], x2 = acc[ai][bj][m][1]; const int c = colbase + bj * 128 + wc * 32 + 4 * fq;
                    if (sect < 2) {
#pragma unroll
                        for (int i = 0; i < 4; ++i) { x1[i] = gelu_tanh(x1[i]); x2[i] = gelu_tanh(x2[i]); }
                        bf16* dst = (sect == 0 ? U : VS) + (size_t)row * 512 + c;
                        v2u o; o.x = cvt_pk_bf16(x1.x, x1.y); o.y = cvt_pk_bf16(x1.z, x1.w); *(GAS v2u*)dst = o; o.x = cvt_pk_bf16(x2.x, x2.y); o.y = cvt_pk_bf16(x2.z, x2.w); *(GAS v2u*)(dst + 16) = o;
                    } else {
                        if (lat) { const int t = row & 8191, pos = (wc & 1) ? (t & 63) : (t >> 6); const float* rp = rope + (size_t)(pos * 16 + 4 * fq) * 2;
                            const f32x4 cs0 = *(const GAS f32x4*)rp, cs1 = *(const GAS f32x4*)(rp + 4);
                            const float cc[4] = {cs0.x, cs0.z, cs1.x, cs1.z}, ss[4] = {cs0.y, cs0.w, cs1.y, cs1.w};
#pragma unroll
                            for (int i = 0; i < 4; ++i) { const float a = x1[i], b = x2[i]; x1[i] = a * cc[i] - b * ss[i]; x2[i] = b * cc[i] + a * ss[i]; } }
                        bf16* dst;
                        if (sect == 2) { x1 = x1 * qscale; x2 = x2 * qscale; dst = Q + (size_t)row * 512 + c; }
                        else { int kr; if (lat) kr = (row >> 13) * KV_LEN + CTXL + (row & 8191); else kr = ((row - NLAT) >> 8) * KV_LEN + ((row - NLAT) & 255); dst = KALL + (size_t)kr * 512 + c; }
                        v2u o; o.x = cvt_pk_bf16(x1.x, x1.y); o.y = cvt_pk_bf16(x1.z, x1.w); *(GAS v2u*)dst = o; o.x = cvt_pk_bf16(x2.x, x2.y); o.y = cvt_pk_bf16(x2.z, x2.w); *(GAS v2u*)(dst + 16) = o;
                    } } } }
    } };
struct EpiSwiglu { static constexpr bool PERM = true; static constexpr bool BIAS_INIT = true; static constexpr float BIAS1_ADD = 1.f; const bf16* b1; bf16* ACT;
    DI void load_bias(const pg8::Unit& u, int wc, int fq, v2u (&b)[2][2]) const { const bf16* bp = b1 + (size_t)u.g * 2048 + u.pn * 128 + wc * 32 + 8 * fq;
        b[0][0] = *(const GAS v2u*)bp; b[0][1] = *(const GAS v2u*)(bp + 4); b[1][0] = *(const GAS v2u*)(bp + 1024); b[1][1] = *(const GAS v2u*)(bp + 1028); }
    DI void operator()(const AccT& acc, const pg8::Unit& u, int wr, int wc, int fr, int fq) const {
        const int c0 = wc * 32 + 8 * fq;
#pragma unroll
        for (int ai = 0; ai < 2; ++ai) { if (ai == 1 && u.half) break;
#pragma unroll
            for (int m = 0; m < 4; ++m) { const int r = u.roff + ai * 128 + wr * 64 + m * 16 + fr; f32x4 o0, o1;
#pragma unroll
                for (int i = 0; i < 4; ++i) {
                    { const float gl = fminf(acc[ai][0][m][0][i], 7.f), l1 = fminf(fmaxf(acc[ai][1][m][0][i], -6.f), 8.f); o0[i] = (gl * l1) * fast_rcp(1.f + fast_exp2(gl * -2.4554669595930157f)); }
                    { const float gl = fminf(acc[ai][0][m][1][i], 7.f), l1 = fminf(fmaxf(acc[ai][1][m][1][i], -6.f), 8.f); o1[i] = (gl * l1) * fast_rcp(1.f + fast_exp2(gl * -2.4554669595930157f)); } }
                v2u o; o.x = pk4_fp8_nc(o0.x, o0.y, o0.z, o0.w); o.y = pk4_fp8_nc(o1.x, o1.y, o1.z, o1.w);
                *(GAS v2u*)((unsigned char*)ACT + (size_t)(u.aux + r) * 1024 + u.pn * 128 + c0) = o; } }
    } };
struct EpiMoe2 { static constexpr bool PERM = true; static constexpr bool BIAS_INIT = true; static constexpr float BIAS1_ADD = 0.f; const bf16* b2; bf16* YT;
    DI void load_bias(const pg8::Unit& u, int wc, int fq, v2u (&b)[2][2]) const { const bf16* bp = b2 + (size_t)u.g * 1024 + u.pn * 256 + wc * 32 + 8 * fq;
#pragma unroll
        for (int bj = 0; bj < 2; ++bj) { b[bj][0] = *(const GAS v2u*)(bp + bj * 128); b[bj][1] = *(const GAS v2u*)(bp + bj * 128 + 4); } }
    DI void operator()(const AccT& acc, const pg8::Unit& u, int wr, int wc, int fr, int fq) const {
        const int cb = u.pn * 256 + wc * 32 + 8 * fq;
#pragma unroll
        for (int ai = 0; ai < 2; ++ai) { if (ai == 1 && u.half) break;
#pragma unroll
            for (int m = 0; m < 4; ++m) { const int r = u.roff + ai * 128 + wr * 64 + m * 16 + fr;
                if (r < u.nvalid) { const int tk = ((const GAS int*)u.rowidx)[r]; unsigned char* rp = (unsigned char*)YT + (size_t)tk * 1024 + cb;
#pragma unroll
                    for (int bj = 0; bj < 2; ++bj) { const f32x4 y0 = acc[ai][bj][m][0], y1 = acc[ai][bj][m][1]; v2u o; o.x = pk4_fp8(y0.x, y0.y, y0.z, y0.w); o.y = pk4_fp8(y1.x, y1.y, y1.z, y1.w);
                        *(GAS v2u*)(rp + bj * 128) = o; } } } }
    } };
DI unsigned brev(unsigned x, int bits) { return __builtin_bitreverse32(x) >> (32 - bits); }
DI void fft8192_unit(Frame& F, const bf16* P, const bf16* Q, unsigned char* dst, float scale) {
    LAS f32x2* X = (LAS f32x2*)F.lds;
    const LAS f32x2* TW = (const LAS f32x2*)(F.lds + 65536);
    for (int i = F.tid; i < 1024; i += 512) { const v4u p = ((const GAS v4u*)P)[i], q = ((const GAS v4u*)Q)[i]; const unsigned pw[4] = {p.x, p.y, p.z, p.w}, qw[4] = {q.x, q.y, q.z, q.w};
#pragma unroll
        for (int e = 0; e < 4; ++e) { X[i * 8 + 2 * e] = (f32x2){bflo(pw[e]), -bflo(qw[e])}; X[i * 8 + 2 * e + 1] = (f32x2){bfhi(pw[e]), -bfhi(qw[e])}; } }
    __syncthreads();
#pragma unroll 1
    for (int h = 4096, sh = 0; h >= 2; h >>= 2, sh += 2) { const int h2 = h >> 1;
#pragma unroll
        for (int u = 0; u < 4; ++u) { const int q = F.tid + 512 * u, j = q & (h2 - 1), i = ((q - j) << 2) | j;
            const f32x2 x0 = X[i], x1 = X[i + h2], x2 = X[i + h], x3 = X[i + h + h2];
            const f32x2 wa = TW[j << sh], wb = TW[(j + h2) << sh], wc = TW[j << (sh + 1)];
            const f32x2 a0 = x0 + x2, d0 = x0 - x2, a1 = x1 + x3, d1 = x1 - x3;
            const f32x2 a2 = {d0.x * wa.x - d0.y * wa.y, d0.x * wa.y + d0.y * wa.x}, a3 = {d1.x * wb.x - d1.y * wb.y, d1.x * wb.y + d1.y * wb.x};
            const f32x2 e0 = a0 - a1, e1 = a2 - a3;
            X[i] = a0 + a1; X[i + h2] = (f32x2){e0.x * wc.x - e0.y * wc.y, e0.x * wc.y + e0.y * wc.x};
            X[i + h] = a2 + a3; X[i + h + h2] = (f32x2){e1.x * wc.x - e1.y * wc.y, e1.x * wc.y + e1.y * wc.x}; }
        __syncthreads();
    }
    {
#pragma unroll
        for (int u = 0; u < 8; ++u) { const int i = 2 * (F.tid + 512 * u); const f32x2 a = X[i], b = X[i + 1]; X[i] = a + b; X[i + 1] = a - b; }
        __syncthreads();
    }
    for (int i = F.tid; i < 8192; i += 512) dst[(size_t)brev(i, 13) * 1024] = f8_1(X[i].x * scale);
    __syncthreads();
}
DI void fft256x8_unit(Frame& F, const bf16* P, const bf16* Q, unsigned char* dst, float scale) {
    LAS f32x2* X = (LAS f32x2*)F.lds + F.wave * 256;
    const LAS f32x2* TW = (const LAS f32x2*)(F.lds + 65536);
#pragma unroll
    for (int u = 0; u < 4; ++u) { const int i = F.lane + 64 * u; X[i] = (f32x2){bf2f(P[i]), -bf2f(Q[i])}; }
    __syncthreads();
#pragma unroll 1
    for (int h = 128, sh = 5; h >= 2; h >>= 2, sh += 2) { const int h2 = h >> 1;
        { const int q = F.lane, j = q & (h2 - 1), i = ((q - j) << 2) | j;
            const f32x2 x0 = X[i], x1 = X[i + h2], x2 = X[i + h], x3 = X[i + h + h2];
            const f32x2 wa = TW[j << sh], wb = TW[(j + h2) << sh], wc = TW[(j << (sh + 1)) & 4095];
            const f32x2 a0 = x0 + x2, d0 = x0 - x2, a1 = x1 + x3, d1 = x1 - x3;
            const f32x2 a2 = {d0.x * wa.x - d0.y * wa.y, d0.x * wa.y + d0.y * wa.x}, a3 = {d1.x * wb.x - d1.y * wb.y, d1.x * wb.y + d1.y * wb.x};
            const f32x2 e0 = a0 - a1, e1 = a2 - a3;
            X[i] = a0 + a1; X[i + h2] = (f32x2){e0.x * wc.x - e0.y * wc.y, e0.x * wc.y + e0.y * wc.x};
            X[i + h] = a2 + a3; X[i + h + h2] = (f32x2){e1.x * wc.x - e1.y * wc.y, e1.x * wc.y + e1.y * wc.x}; }
        __syncthreads();
    }
#pragma unroll
    for (int u = 0; u < 4; ++u) { const int i = F.lane + 64 * u; dst[(size_t)brev(i, 8) * 1024] = f8_1(X[i].x * scale); }
    __syncthreads();
}
DI void fft_phase(Frame& F, bool rev_order) {
    unsigned char* const ws = WSP(F);
    { const GAS f32x2* tw = (const GAS f32x2*)(ws + WS_TW); LAS f32x2* T = (LAS f32x2*)(F.lds + 65536); for (int i = F.tid; i < 4096; i += 512) T[i] = tw[i]; }
    __syncthreads();
    const bf16* PQ = (const bf16*)(ws + WS_PQT); unsigned char* CAT = ws + WS_CAT;
    const int c = rev_order ? (F.G - 1 - F.vcu) : F.vcu;
    for (int it = c; it < 1024 + 128; it += F.G) {
        if (it < 1024) { const int b = it >> 8, col = it & 255;
            fft8192_unit(F, PQ + (size_t)col * NTOK + b * SEQ, PQ + (size_t)(256 + col) * NTOK + b * SEQ, CAT + (size_t)b * SEQ * 1024 + col, 1.f / 724.0773439350247f);
        } else { const int r = it - 1024, b = r >> 5, col = (r & 31) * 8 + F.wave;
            fft256x8_unit(F, PQ + (size_t)col * NTOK + NLAT + b * CTXL, PQ + (size_t)(256 + col) * NTOK + NLAT + b * CTXL, CAT + (size_t)(NLAT + b * CTXL) * 1024 + col, 1.f / 128.f); }
    }
}

DI void s5_carry_phase(Frame& F, int j) {
    unsigned char* const ws = WSP(F);
    const int gw = F.wave * F.G + F.vcu, NGW = F.G * 8;
    const float* SL = (const float*)(ws + WS_SLOC); bf16* UG = (bf16*)(ws + WS_UG);
    for (int it = gw; it < 4 * 48 * 2; it += NGW) {
        const int dir = it & 1, g = (it >> 1) % 48, b = it / 96;
        const f32x2 aT = ((const GAS f32x2*)(ws + WS_APT))[((size_t)(j * 2 + dir) * 48 + g) * 64 + F.lane];
        float hr = 0.f, hi = 0.f;
#define S5C_ROW(s) ((s) < 8 ? 1024 + b * 8 + (dir ? 7 - (s) : (s)) : b * 256 + (dir ? 255 - ((s) - 8) : ((s) - 8)))
#define S5C_LOAD(buf, s0_) do { _Pragma("unroll") for (int e = 0; e < 24; ++e) { const int r_ = S5C_ROW((s0_) + e); buf[e] = *(const GAS f32x2*)(SL + ((size_t)g * S5ROWS + r_) * 256 + dir * 128 + 2 * F.lane); } } while (0)
#define S5C_STEP(buf, s0_) do { _Pragma("unroll") for (int e = 0; e < 24; ++e) { const int r_ = S5C_ROW((s0_) + e); \
            *(GAS unsigned*)(UG + ((size_t)g * S5ROWS + r_) * S5K + 512 + dir * 128 + 2 * F.lane) = pk2(hr, hi); \
            const float nr = aT.x * hr - aT.y * hi + buf[e].x, ni = aT.x * hi + aT.y * hr + buf[e].y; hr = nr; hi = ni; } } while (0)
        f32x2 svA[24], svB[24];
        S5C_LOAD(svA, 0);
#pragma unroll 1
        for (int s0 = 0; s0 < 264; s0 += 48) {
            const bool second = s0 + 24 < 264;
            if (second) S5C_LOAD(svB, s0 + 24);
            S5C_STEP(svA, s0);
            if (second) { if (s0 + 48 < 264) S5C_LOAD(svA, s0 + 48); S5C_STEP(svB, s0 + 24); }
        }
#undef S5C_ROW
#undef S5C_LOAD
#undef S5C_STEP
    }
}

DI void sgu_unit(Frame& F, CArgsP a, int j, int cr, int g) {
    unsigned char* const ws = WSP(F);
    LAS bf16* VN = (LAS bf16*)F.lds;
    const int row0 = cr * 128;
    const bf16* VS = (const bf16*)(ws + WS_VS); const bf16* U = (const bf16*)(ws + WS_U); unsigned char* CAT = ws + WS_CAT;
    {
        const int p = F.tid >> 2, part = F.tid & 3; float x[32];
        const GAS v4u* src = (const GAS v4u*)(VS + (size_t)(row0 + p) * 512 + g * 128 + part * 32);
#pragma unroll
        for (int q = 0; q < 4; ++q) { const v4u w = src[q]; const unsigned ww[4] = {w.x, w.y, w.z, w.w};
#pragma unroll
            for (int e = 0; e < 4; ++e) { x[q * 8 + 2 * e] = bflo(ww[e]); x[q * 8 + 2 * e + 1] = bfhi(ww[e]); } }
        float s = 0.f;
#pragma unroll
        for (int i = 0; i < 32; ++i) s += x[i];
        s += __shfl_xor(s, 1); s += __shfl_xor(s, 2);
        const float mu = s * (1.f / 128.f); float v = 0.f;
#pragma unroll
        for (int i = 0; i < 32; ++i) { x[i] -= mu; v += x[i] * x[i]; }
        v += __shfl_xor(v, 1); v += __shfl_xor(v, 2);
        const float rstd = 1.f / sqrtf(v * (1.f / 128.f) + EPS);
        const float* lg = a->in[I_SGULNG] + (size_t)(j * 4 + g) * 128 + part * 32; const float* lb = a->in[I_SGULNB] + (size_t)(j * 4 + g) * 128 + part * 32;
#pragma unroll
        for (int i = 0; i < 32; ++i) VN[(part * 32 + i) * 136 + p] = (bf16)f2bf(x[i] * rstd * lg[i] + lb[i]);
    }
    __syncthreads();
    const int r = F.lane & 31, h = F.lane >> 5, qb = F.wave >> 1, ch = F.wave & 1;
    const bf16* Wg = (const bf16*)(ws + WS_SGUW) + (size_t)(j * 4 + g) * 16384 + (size_t)(qb * 32 + r) * 128;
    f32x16 acc[2];
#pragma unroll
    for (int i = 0; i < 16; ++i) { acc[0][i] = 0.f; acc[1][i] = 0.f; }
#pragma unroll
    for (int ks = 0; ks < 8; ++ks) { const bf16x8 af = *(const GAS bf16x8*)(Wg + ks * 16 + 8 * h);
#pragma unroll
        for (int ct = 0; ct < 2; ++ct) { const bf16x8 bfm = *(const LAS bf16x8*)(VN + (ch * 64 + ct * 32 + r) * 136 + ks * 16 + 8 * h);
            acc[ct] = __builtin_amdgcn_mfma_f32_32x32x16_bf16(bfm, af, acc[ct], 0, 0, 0); } }
    const int q = qb * 32 + r; const float bq = a->in[I_SGUB][(size_t)(j * 4 + g) * 128 + q];
    const bf16* up = U + (size_t)(row0 + q) * 512 + g * 128 + ch * 64 + 4 * h; unsigned char* cp = CAT + (size_t)(row0 + q) * 1024 + g * 128 + ch * 64 + 4 * h;
#pragma unroll
    for (int ct = 0; ct < 2; ++ct)
#pragma unroll
        for (int q4 = 0; q4 < 4; ++q4) { const int co = ct * 32 + 8 * q4; const v2u uw = *(const GAS v2u*)(up + co);
            *(GAS unsigned*)(cp + co) = pk4_fp8(bflo(uw.x) * (acc[ct][4 * q4] + bq), bfhi(uw.x) * (acc[ct][4 * q4 + 1] + bq), bflo(uw.y) * (acc[ct][4 * q4 + 2] + bq), bfhi(uw.y) * (acc[ct][4 * q4 + 3] + bq)); }
    __syncthreads();
}

DI bf16x8 pack_step(const f32x16& x, int s) {
    v4u p; p.x = cvt_pk_bf16(x[8 * s], x[8 * s + 1]); p.y = cvt_pk_bf16(x[8 * s + 2], x[8 * s + 3]); p.z = cvt_pk_bf16(x[8 * s + 4], x[8 * s + 5]); p.w = cvt_pk_bf16(x[8 * s + 6], x[8 * s + 7]);
    return __builtin_bit_cast(bf16x8, p);
}
constexpr int AT_KROW = 144, AT_VROW = 272;
constexpr int AT_KBYTES = 128 * AT_KROW, AT_VBYTES = 128 * AT_VROW, AT_STAGE = AT_KBYTES + AT_VBYTES;
constexpr float AT_THR = 12.f;
DI float max3f(float a, float b, float c) { return fmaxf(fmaxf(a, b), c); }
DI void attn_pass(Frame& F, const bf16* Qrow, const bf16* Kb, const bf16* Vb, int nkt, int rot, f32x16 (&O)[4], float& lsum) {
    const int r = F.lane & 31, h = F.lane >> 5;
    bf16x8 qf[4];
#pragma unroll
    for (int ds = 0; ds < 4; ++ds) qf[ds] = *(const GAS bf16x8*)(Qrow + ds * 16 + 8 * h);
    const f32x16 ZERO16 = {0.f, 0.f, 0.f, 0.f, 0.f, 0.f, 0.f, 0.f, 0.f, 0.f, 0.f, 0.f, 0.f, 0.f, 0.f, 0.f};
#pragma unroll
    for (int d = 0; d < 4; ++d) O[d] = ZERO16;
    float mref = 0.f;
#pragma unroll
    for (int ds = 0; ds < 4; ++ds) { const bf16x8 kv = *(const GAS bf16x8*)(Kb + ds * 16 + 8 * h);
#pragma unroll
        for (int e = 0; e < 8; ++e) mref += bf2f((unsigned short)qf[ds][e]) * bf2f((unsigned short)kv[e]); }
    mref += __shfl_xor(mref, 32);
    lsum = 0.f;
    const unsigned kgo = (unsigned)((F.tid >> 3) * 1024 + (F.tid & 7) * 16), vgo = (unsigned)((F.tid >> 4) * (KV_LEN * 2) + (F.tid & 15) * 16);
    const int kl = (F.tid >> 3) * AT_KROW + (F.tid & 7) * 16, vl = AT_KBYTES + (F.tid >> 4) * AT_VROW + ((F.tid & 15) >> 1) * 32 + (F.tid & 1) * 8;
    const char* kbase = (const char*)Kb; const char* vbase = (const char*)Vb;
#define AT_LOADK(i, t) (*(const GAS v4u*)(kbase + (size_t)(t) * (128 * 1024) + (size_t)(i) * (64 * 1024) + kgo))
#define AT_LOADV(i, t) (*(const GAS v4u*)(vbase + (size_t)(t) * 256 + (size_t)(i) * (32 * KV_LEN * 2) + vgo))
#define AT_STORE(stp) do { _Pragma("unroll") for (int i_ = 0; i_ < 2; ++i_) *(LAS v4u*)((stp) + kl + i_ * (64 * AT_KROW)) = kr[i_]; \
        _Pragma("unroll") for (int i_ = 0; i_ < 4; ++i_) { *(LAS v2u*)((stp) + vl + i_ * (32 * AT_VROW)) = (v2u){vr[i_].x, vr[i_].y}; *(LAS v2u*)((stp) + vl + i_ * (32 * AT_VROW) + 16) = (v2u){vr[i_].z, vr[i_].w}; } } while (0)
    v4u kr[2], vr[4];
#pragma unroll
    for (int i = 0; i < 2; ++i) kr[i] = AT_LOADK(i, rot);
#pragma unroll
    for (int i = 0; i < 4; ++i) vr[i] = AT_LOADV(i, rot);
    AT_STORE(F.lds);
    __syncthreads();
    const unsigned lbase = (unsigned)(size_t)F.lds;
    const unsigned ka0 = lbase + r * AT_KROW + h * 16, va00 = lbase + AT_KBYTES + r * AT_VROW + 16 * h;
    bf16x8 kf[4], vf[4];
    f32x16 XA, XB;
#pragma unroll 1
    for (int kt = 0; kt < nkt; ++kt) {
        const unsigned so = (unsigned)((kt & 1) * AT_STAGE);
        const unsigned ka = ka0 + so, va0 = va00 + so, va1 = va0 + 32 * AT_VROW, va2 = va0 + 64 * AT_VROW, va3 = va0 + 96 * AT_VROW;
        asm volatile("ds_read_b128 %0, %4 offset:0\n\tds_read_b128 %1, %4 offset:32\n\tds_read_b128 %2, %4 offset:64\n\tds_read_b128 %3, %4 offset:96" : "=&v"(kf[0]), "=&v"(kf[1]), "=&v"(kf[2]), "=&v"(kf[3]) : "v"(ka) : "memory");
        if (kt + 1 < nkt) { int tn = kt + 1 + rot; tn = tn >= nkt ? tn - nkt : tn;
#pragma unroll
            for (int i = 0; i < 2; ++i) kr[i] = AT_LOADK(i, tn);
#pragma unroll
            for (int i = 0; i < 4; ++i) vr[i] = AT_LOADV(i, tn); }
        asm volatile("s_waitcnt lgkmcnt(0)" : "+v"(kf[0]), "+v"(kf[1]), "+v"(kf[2]), "+v"(kf[3]) :: "memory");
        XA = __builtin_amdgcn_mfma_f32_32x32x16_bf16(kf[0], qf[0], ZERO16, 0, 0, 0);
            XA = __builtin_amdgcn_mfma_f32_32x32x16_bf16(kf[1], qf[1], XA, 0, 0, 0);
            XA = __builtin_amdgcn_mfma_f32_32x32x16_bf16(kf[2], qf[2], XA, 0, 0, 0);
            XA = __builtin_amdgcn_mfma_f32_32x32x16_bf16(kf[3], qf[3], XA, 0, 0, 0);
        asm volatile("ds_read_b128 %0, %4 offset:4608\n\tds_read_b128 %1, %4 offset:4640\n\tds_read_b128 %2, %4 offset:4672\n\tds_read_b128 %3, %4 offset:4704" : "=&v"(kf[0]), "=&v"(kf[1]), "=&v"(kf[2]), "=&v"(kf[3]) : "v"(ka) : "memory");
        asm volatile("ds_read_b128 %0, %4 offset:0\n\tds_read_b128 %1, %5 offset:0\n\tds_read_b128 %2, %6 offset:0\n\tds_read_b128 %3, %7 offset:0" : "=&v"(vf[0]), "=&v"(vf[1]), "=&v"(vf[2]), "=&v"(vf[3]) : "v"(va0), "v"(va1), "v"(va2), "v"(va3) : "memory");

        {
            asm volatile("s_waitcnt lgkmcnt(0)" : "+v"(kf[0]), "+v"(kf[1]), "+v"(kf[2]), "+v"(kf[3]), "+v"(vf[0]), "+v"(vf[1]), "+v"(vf[2]), "+v"(vf[3]) :: "memory");
            XB = __builtin_amdgcn_mfma_f32_32x32x16_bf16(kf[0], qf[0], ZERO16, 0, 0, 0);
            XB = __builtin_amdgcn_mfma_f32_32x32x16_bf16(kf[1], qf[1], XB, 0, 0, 0);
            XB = __builtin_amdgcn_mfma_f32_32x32x16_bf16(kf[2], qf[2], XB, 0, 0, 0);
            XB = __builtin_amdgcn_mfma_f32_32x32x16_bf16(kf[3], qf[3], XB, 0, 0, 0);
            float mx = max3f(XA[0], XA[1], XA[2]);
#pragma unroll
            for (int i = 3; i < 15; i += 2) mx = max3f(mx, XA[i], XA[i + 1]);
            mx = fmaxf(mx, XA[15]) - mref;
            if (__builtin_amdgcn_ballot_w64(mx > AT_THR) != 0ull) {
                const float mo = fmaxf(mx, __shfl_xor(mx, 32)); const float delta = mo > AT_THR ? mo : 0.f, alpha = fast_exp2(-delta);
                mref += delta; lsum *= alpha;
#pragma unroll
                for (int d = 0; d < 4; ++d)
#pragma unroll
                    for (int i = 0; i < 16; ++i) O[d][i] *= alpha;
            }
            float ps0 = 0.f, ps1 = 0.f;
#pragma unroll
            for (int i = 0; i < 16; i += 2) { const float p0 = fast_exp2(XA[i] - mref), p1 = fast_exp2(XA[i + 1] - mref); XA[i] = p0; XA[i + 1] = p1; ps0 += p0; ps1 += p1; }
            lsum += ps0 + ps1;
            const bf16x8 pb0 = pack_step(XA, 0), pb1 = pack_step(XA, 1);
#pragma unroll
            for (int d = 0; d < 4; ++d) O[d] = __builtin_amdgcn_mfma_f32_32x32x16_bf16(vf[d], pb0, O[d], 0, 0, 0);
            asm volatile("ds_read_b128 %0, %4 offset:32\n\tds_read_b128 %1, %5 offset:32\n\tds_read_b128 %2, %6 offset:32\n\tds_read_b128 %3, %7 offset:32" : "=&v"(vf[0]), "=&v"(vf[1]), "=&v"(vf[2]), "=&v"(vf[3]) : "v"(va0), "v"(va1), "v"(va2), "v"(va3) : "memory");
            asm volatile("ds_read_b128 %0, %4 offset:9216\n\tds_read_b128 %1, %4 offset:9248\n\tds_read_b128 %2, %4 offset:9280\n\tds_read_b128 %3, %4 offset:9312" : "=&v"(kf[0]), "=&v"(kf[1]), "=&v"(kf[2]), "=&v"(kf[3]) : "v"(ka) : "memory");
            asm volatile("s_waitcnt lgkmcnt(0)" : "+v"(kf[0]), "+v"(kf[1]), "+v"(kf[2]), "+v"(kf[3]), "+v"(vf[0]), "+v"(vf[1]), "+v"(vf[2]), "+v"(vf[3]) :: "memory");
#pragma unroll
            for (int d = 0; d < 4; ++d) O[d] = __builtin_amdgcn_mfma_f32_32x32x16_bf16(vf[d], pb1, O[d], 0, 0, 0);
            asm volatile("ds_read_b128 %0, %4 offset:64\n\tds_read_b128 %1, %5 offset:64\n\tds_read_b128 %2, %6 offset:64\n\tds_read_b128 %3, %7 offset:64" : "=&v"(vf[0]), "=&v"(vf[1]), "=&v"(vf[2]), "=&v"(vf[3]) : "v"(va0), "v"(va1), "v"(va2), "v"(va3) : "memory");
        }
        {
            asm volatile("s_waitcnt lgkmcnt(0)" : "+v"(kf[0]), "+v"(kf[1]), "+v"(kf[2]), "+v"(kf[3]), "+v"(vf[0]), "+v"(vf[1]), "+v"(vf[2]), "+v"(vf[3]) :: "memory");
            XA = __builtin_amdgcn_mfma_f32_32x32x16_bf16(kf[0], qf[0], ZERO16, 0, 0, 0);
            XA = __builtin_amdgcn_mfma_f32_32x32x16_bf16(kf[1], qf[1], XA, 0, 0, 0);
            XA = __builtin_amdgcn_mfma_f32_32x32x16_bf16(kf[2], qf[2], XA, 0, 0, 0);
            XA = __builtin_amdgcn_mfma_f32_32x32x16_bf16(kf[3], qf[3], XA, 0, 0, 0);
            float mx = max3f(XB[0], XB[1], XB[2]);
#pragma unroll
            for (int i = 3; i < 15; i += 2) mx = max3f(mx, XB[i], XB[i + 1]);
            mx = fmaxf(mx, XB[15]) - mref;
            if (__builtin_amdgcn_ballot_w64(mx > AT_THR) != 0ull) {
                const float mo = fmaxf(mx, __shfl_xor(mx, 32)); const float delta = mo > AT_THR ? mo : 0.f, alpha = fast_exp2(-delta);
                mref += delta; lsum *= alpha;
#pragma unroll
                for (int d = 0; d < 4; ++d)
#pragma unroll
                    for (int i = 0; i < 16; ++i) O[d][i] *= alpha;
            }
            float ps0 = 0.f, ps1 = 0.f;
#pragma unroll
            for (int i = 0; i < 16; i += 2) { const float p0 = fast_exp2(XB[i] - mref), p1 = fast_exp2(XB[i + 1] - mref); XB[i] = p0; XB[i + 1] = p1; ps0 += p0; ps1 += p1; }
            lsum += ps0 + ps1;
            const bf16x8 pb0 = pack_step(XB, 0), pb1 = pack_step(XB, 1);
#pragma unroll
            for (int d = 0; d < 4; ++d) O[d] = __builtin_amdgcn_mfma_f32_32x32x16_bf16(vf[d], pb0, O[d], 0, 0, 0);
            asm volatile("ds_read_b128 %0, %4 offset:96\n\tds_read_b128 %1, %5 offset:96\n\tds_read_b128 %2, %6 offset:96\n\tds_read_b128 %3, %7 offset:96" : "=&v"(vf[0]), "=&v"(vf[1]), "=&v"(vf[2]), "=&v"(vf[3]) : "v"(va0), "v"(va1), "v"(va2), "v"(va3) : "memory");
            asm volatile("ds_read_b128 %0, %4 offset:13824\n\tds_read_b128 %1, %4 offset:13856\n\tds_read_b128 %2, %4 offset:13888\n\tds_read_b128 %3, %4 offset:13920" : "=&v"(kf[0]), "=&v"(kf[1]), "=&v"(kf[2]), "=&v"(kf[3]) : "v"(ka) : "memory");
            asm volatile("s_waitcnt lgkmcnt(0)" : "+v"(kf[0]), "+v"(kf[1]), "+v"(kf[2]), "+v"(kf[3]), "+v"(vf[0]), "+v"(vf[1]), "+v"(vf[2]), "+v"(vf[3]) :: "memory");
#pragma unroll
            for (int d = 0; d < 4; ++d) O[d] = __builtin_amdgcn_mfma_f32_32x32x16_bf16(vf[d], pb1, O[d], 0, 0, 0);
            asm volatile("ds_read_b128 %0, %4 offset:128\n\tds_read_b128 %1, %5 offset:128\n\tds_read_b128 %2, %6 offset:128\n\tds_read_b128 %3, %7 offset:128" : "=&v"(vf[0]), "=&v"(vf[1]), "=&v"(vf[2]), "=&v"(vf[3]) : "v"(va0), "v"(va1), "v"(va2), "v"(va3) : "memory");
        }
        {
            asm volatile("s_waitcnt lgkmcnt(0)" : "+v"(kf[0]), "+v"(kf[1]), "+v"(kf[2]), "+v"(kf[3]), "+v"(vf[0]), "+v"(vf[1]), "+v"(vf[2]), "+v"(vf[3]) :: "memory");
            XB = __builtin_amdgcn_mfma_f32_32x32x16_bf16(kf[0], qf[0], ZERO16, 0, 0, 0);
            XB = __builtin_amdgcn_mfma_f32_32x32x16_bf16(kf[1], qf[1], XB, 0, 0, 0);
            XB = __builtin_amdgcn_mfma_f32_32x32x16_bf16(kf[2], qf[2], XB, 0, 0, 0);
            XB = __builtin_amdgcn_mfma_f32_32x32x16_bf16(kf[3], qf[3], XB, 0, 0, 0);
            float mx = max3f(XA[0], XA[1], XA[2]);
#pragma unroll
            for (int i = 3; i < 15; i += 2) mx = max3f(mx, XA[i], XA[i + 1]);
            mx = fmaxf(mx, XA[15]) - mref;
            if (__builtin_amdgcn_ballot_w64(mx > AT_THR) != 0ull) {
                const float mo = fmaxf(mx, __shfl_xor(mx, 32)); const float delta = mo > AT_THR ? mo : 0.f, alpha = fast_exp2(-delta);
                mref += delta; lsum *= alpha;
#pragma unroll
                for (int d = 0; d < 4; ++d)
#pragma unroll
                    for (int i = 0; i < 16; ++i) O[d][i] *= alpha;
            }
            float ps0 = 0.f, ps1 = 0.f;
#pragma unroll
            for (int i = 0; i < 16; i += 2) { const float p0 = fast_exp2(XA[i] - mref), p1 = fast_exp2(XA[i + 1] - mref); XA[i] = p0; XA[i + 1] = p1; ps0 += p0; ps1 += p1; }
            lsum += ps0 + ps1;
            const bf16x8 pb0 = pack_step(XA, 0), pb1 = pack_step(XA, 1);
#pragma unroll
            for (int d = 0; d < 4; ++d) O[d] = __builtin_amdgcn_mfma_f32_32x32x16_bf16(vf[d], pb0, O[d], 0, 0, 0);
            asm volatile("ds_read_b128 %0, %4 offset:160\n\tds_read_b128 %1, %5 offset:160\n\tds_read_b128 %2, %6 offset:160\n\tds_read_b128 %3, %7 offset:160" : "=&v"(vf[0]), "=&v"(vf[1]), "=&v"(vf[2]), "=&v"(vf[3]) : "v"(va0), "v"(va1), "v"(va2), "v"(va3) : "memory");

            asm volatile("s_waitcnt lgkmcnt(0)" : "+v"(kf[0]), "+v"(kf[1]), "+v"(kf[2]), "+v"(kf[3]), "+v"(vf[0]), "+v"(vf[1]), "+v"(vf[2]), "+v"(vf[3]) :: "memory");
#pragma unroll
            for (int d = 0; d < 4; ++d) O[d] = __builtin_amdgcn_mfma_f32_32x32x16_bf16(vf[d], pb1, O[d], 0, 0, 0);
            asm volatile("ds_read_b128 %0, %4 offset:192\n\tds_read_b128 %1, %5 offset:192\n\tds_read_b128 %2, %6 offset:192\n\tds_read_b128 %3, %7 offset:192" : "=&v"(vf[0]), "=&v"(vf[1]), "=&v"(vf[2]), "=&v"(vf[3]) : "v"(va0), "v"(va1), "v"(va2), "v"(va3) : "memory");
        }
        {
            asm volatile("s_waitcnt lgkmcnt(0)" : "+v"(kf[0]), "+v"(kf[1]), "+v"(kf[2]), "+v"(kf[3]), "+v"(vf[0]), "+v"(vf[1]), "+v"(vf[2]), "+v"(vf[3]) :: "memory");
            float mx = max3f(XB[0], XB[1], XB[2]);
#pragma unroll
            for (int i = 3; i < 15; i += 2) mx = max3f(mx, XB[i], XB[i + 1]);
            mx = fmaxf(mx, XB[15]) - mref;
            if (__builtin_amdgcn_ballot_w64(mx > AT_THR) != 0ull) {
                const float mo = fmaxf(mx, __shfl_xor(mx, 32)); const float delta = mo > AT_THR ? mo : 0.f, alpha = fast_exp2(-delta);
                mref += delta; lsum *= alpha;
#pragma unroll
                for (int d = 0; d < 4; ++d)
#pragma unroll
                    for (int i = 0; i < 16; ++i) O[d][i] *= alpha;
            }
            float ps0 = 0.f, ps1 = 0.f;
#pragma unroll
            for (int i = 0; i < 16; i += 2) { const float p0 = fast_exp2(XB[i] - mref), p1 = fast_exp2(XB[i + 1] - mref); XB[i] = p0; XB[i + 1] = p1; ps0 += p0; ps1 += p1; }
            lsum += ps0 + ps1;
            const bf16x8 pb0 = pack_step(XB, 0), pb1 = pack_step(XB, 1);
#pragma unroll
            for (int d = 0; d < 4; ++d) O[d] = __builtin_amdgcn_mfma_f32_32x32x16_bf16(vf[d], pb0, O[d], 0, 0, 0);
            asm volatile("ds_read_b128 %0, %4 offset:224\n\tds_read_b128 %1, %5 offset:224\n\tds_read_b128 %2, %6 offset:224\n\tds_read_b128 %3, %7 offset:224" : "=&v"(vf[0]), "=&v"(vf[1]), "=&v"(vf[2]), "=&v"(vf[3]) : "v"(va0), "v"(va1), "v"(va2), "v"(va3) : "memory");

            asm volatile("s_waitcnt lgkmcnt(0)" : "+v"(kf[0]), "+v"(kf[1]), "+v"(kf[2]), "+v"(kf[3]), "+v"(vf[0]), "+v"(vf[1]), "+v"(vf[2]), "+v"(vf[3]) :: "memory");
#pragma unroll
            for (int d = 0; d < 4; ++d) O[d] = __builtin_amdgcn_mfma_f32_32x32x16_bf16(vf[d], pb1, O[d], 0, 0, 0);

        }
        if (kt + 1 < nkt) { LAS unsigned char* sn = F.lds + ((kt + 1) & 1) * AT_STAGE; AT_STORE(sn); }
        __syncthreads();
    }
    lsum += __shfl_xor(lsum, 32);
#undef AT_LOADK
#undef AT_LOADV
#undef AT_STORE
}

DI void attn_unit(Frame& F, CArgsP a, int jl, int layer, int qrow0, int b, int hd, int nkeys) {
    unsigned char* const ws = WSP(F);
    const int r = F.lane & 31, h = F.lane >> 5;
    const int qrow = qrow0 + F.wave * 32 + r;
    const bf16* Qp = (const bf16*)(ws + WS_Q) + (size_t)qrow * 512 + hd * 128;
    const bf16* Kp = (const bf16*)(ws + WS_KALL) + (size_t)b * KV_LEN * 512 + hd * 128;
    const bf16* Vp = (const bf16*)(ws + WS_VT) + ((size_t)b * 512 + hd * 128) * KV_LEN;
    const float lam = ((const float*)(ws + WS_CB))[jl * 2], lam_init = ((const float*)(ws + WS_CB))[jl * 2 + 1];
    f32x16 O[4]; float l1, l2;
    unsigned char* dst = ws + WS_CAT + (size_t)qrow * 1024 + 512 + hd * 128;
    bf16* park = (bf16*)(ws + WS_CAT + (size_t)NTOK * 1024) + (size_t)qrow * 512 + hd * 128;
    const int nkt = nkeys / 128, rot = (nkt >= 64) ? (int)(((F.vcu >> 3) & 31) * 2) : 0;
    attn_pass(F, Qp, Kp, Vp, nkt, rot, O, l1);
    { const float inv = 1.f / l1;
#pragma unroll
      for (int d = 0; d < 4; ++d)
#pragma unroll
          for (int q4 = 0; q4 < 4; ++q4) { const int dv = d * 32 + 8 * q4 + 4 * h;
              v2u o; o.x = cvt_pk_bf16(O[d][4 * q4] * inv, O[d][4 * q4 + 1] * inv); o.y = cvt_pk_bf16(O[d][4 * q4 + 2] * inv, O[d][4 * q4 + 3] * inv);
              *(GAS v2u*)(park + dv) = o; } }
    attn_pass(F, Qp + 64, Kp + 64, Vp, nkt, rot, O, l2);
    { const float inv = lam / l2; float ss = 0.f;
#pragma unroll
      for (int d = 0; d < 4; ++d)
#pragma unroll
          for (int q4 = 0; q4 < 4; ++q4) { const int dv = d * 32 + 8 * q4 + 4 * h; const v2u w = *(const GAS v2u*)(park + dv);
              const float x0 = bflo(w.x) - O[d][4 * q4] * inv, x1 = bfhi(w.x) - O[d][4 * q4 + 1] * inv, x2 = bflo(w.y) - O[d][4 * q4 + 2] * inv, x3 = bfhi(w.y) - O[d][4 * q4 + 3] * inv;
              O[d][4 * q4] = x0; O[d][4 * q4 + 1] = x1; O[d][4 * q4 + 2] = x2; O[d][4 * q4 + 3] = x3; ss += (x0 * x0 + x1 * x1) + (x2 * x2 + x3 * x3); }
      ss += __shfl_xor(ss, 32);
      const float sc = (1.f / sqrtf(ss * (1.f / 128.f) + EPS)) * (1.f - lam_init);
      const float* sg = a->in[I_SUBLN] + jl * 128;
#pragma unroll
      for (int d = 0; d < 4; ++d)
#pragma unroll
          for (int q4 = 0; q4 < 4; ++q4) { const int dv = d * 32 + 8 * q4 + 4 * h; const f32x4 g = *(const GAS f32x4*)(sg + dv);
              *(GAS unsigned*)(dst + dv) = pk4_fp8(O[d][4 * q4] * sc * g.x, O[d][4 * q4 + 1] * sc * g.y, O[d][4 * q4 + 2] * sc * g.z, O[d][4 * q4 + 3] * sc * g.w); } }
}
DI void moe_tables(Frame& F, int layer, int nN) {
    LAS int* tab = (LAS int*)(F.lds + TAB_OFF);
    __syncthreads();
    if (F.wave == 0) {
        const int e = F.lane & 31;
        const int c = (int)__hip_atomic_load(F.ctl + CW_CNT + layer * 32 + e, RLX_AGENT), mt = (c + 255) >> 8;
        int incl = mt;
#pragma unroll
        for (int o = 1; o < 32; o <<= 1) { const int t = __shfl_up(incl, o, 32); if (e >= o) incl += t; }
        const int excl = incl - mt;
        if (F.lane < 32) { tab[e] = excl * 256; tab[33 + e] = excl * nN; tab[66 + e] = mt; tab[98 + e] = c;
            if (e == 31) { tab[32] = incl * 256; tab[65] = incl * nN; } }
    }
    __syncthreads();
}

DI float rt_key(float logit, int e) { unsigned kb = __builtin_bit_cast(unsigned, logit); kb = (kb & 0xFFFFFFE0u) | ((kb >> 31) ? (unsigned)e : (unsigned)(31 - e)); return __builtin_bit_cast(float, kb); }
DI void router_phase(Frame& F, CArgsP a, int layer, int cnt_slot) {
    unsigned char* const ws = WSP(F);
    LAS unsigned char* rwh = F.lds;
    LAS unsigned char* rwl = F.lds + 32 * RT_PITCH;
    LAS int* hist = (LAS int*)(F.lds + 64 * RT_PITCH);
    LAS int* base = hist + 32;
    LAS int* rec_e = base + 32;
    LAS int* rec_r = rec_e + 1024;
    LAS float* rec_g = (LAS float*)(rec_r + 1024);
    const float* RW = a->in[I_RW] + (size_t)layer * 1024 * 32; const float* RB = a->in[I_RB] + layer * 32;
    { const GAS v4u* img = (const GAS v4u*)(ws + WS_RIMG + (size_t)layer * (64 * RT_PITCH));
      for (int i = F.tid; i < 64 * RT_PITCH / 16; i += 512) ((LAS v4u*)F.lds)[i] = img[i]; }
    if (F.tid < 32) hist[F.tid] = 0;
    __syncthreads();
    const int nrows_all = (layer == 3) ? NLAT : NTOK, ntask = nrows_all >> 4;
    const bf16* H = (const bf16*)(ws + WS_H); bf16* XN = (bf16*)(ws + WS_XN);
    const int l = F.lane, tkn = l & 15, kg = l >> 4;
    const unsigned fa0 = (unsigned)(size_t)rwh + tkn * RT_PITCH + kg * 16, fa1 = fa0 + 16 * RT_PITCH, fl0 = fa0 + 32 * RT_PITCH, fl1 = fa1 + 32 * RT_PITCH;
#pragma unroll 1
    for (int slot = 0; slot < 2; ++slot) {
        int task;
        if (slot == 0) task = (int)blockIdx.x * 8 + F.wave; else { if (F.wave != 0 || (blockIdx.x & 3) != 0) break; task = 2048 + (int)(blockIdx.x >> 2); }
        if (task >= ntask) break;
        const int row0 = task * 16, mr = mod_row(row0);
        const bf16* hp = H + (size_t)(row0 + tkn) * 1024 + 8 * kg;
        const float* am = (const float*)(ws + WS_AM) + (size_t)(layer * 5 + mr) * 1024 + 8 * kg;
        const float* bm = (const float*)(ws + WS_MOD) + (size_t)(layer * 5 + mr) * 6144 + 3 * 1024 + 8 * kg;
        float ss = 0.f;
        { v4u hq[32];
#pragma unroll
          for (int s = 0; s < 32; ++s) hq[s] = *(const GAS v4u*)(hp + 32 * s);
#pragma unroll
          for (int s = 0; s < 32; ++s) { const v4u hw = hq[s]; const float h[8] = {bflo(hw.x), bfhi(hw.x), bflo(hw.y), bfhi(hw.y), bflo(hw.z), bfhi(hw.z), bflo(hw.w), bfhi(hw.w)};
#pragma unroll
              for (int j = 0; j < 8; ++j) ss += h[j] * h[j]; } }
        ss += __shfl_xor(ss, 16); ss += __shfl_xor(ss, 32);
        const float rstd = 1.f / sqrtf(ss * (1.f / 1024.f) + EPS);
        f32x4 acc0 = {0.f, 0.f, 0.f, 0.f}, acc1 = {0.f, 0.f, 0.f, 0.f};
#pragma unroll
        for (int s = 0; s < 32; ++s) {
            if ((s & 7) == 0) asm volatile("" ::: "memory");
            const v4u hw = *(const GAS v4u*)(hp + 32 * s); const f32x4 a0 = *(const GAS f32x4*)(am + 32 * s), a1 = *(const GAS f32x4*)(am + 32 * s + 4);
            const f32x4 b0 = *(const GAS f32x4*)(bm + 32 * s), b1 = *(const GAS f32x4*)(bm + 32 * s + 4);
            const float h[8] = {bflo(hw.x), bfhi(hw.x), bflo(hw.y), bfhi(hw.y), bflo(hw.z), bfhi(hw.z), bflo(hw.w), bfhi(hw.w)};
            const float av[8] = {a0.x, a0.y, a0.z, a0.w, a1.x, a1.y, a1.z, a1.w}, bv[8] = {b0.x, b0.y, b0.z, b0.w, b1.x, b1.y, b1.z, b1.w};
            float u[8];
#pragma unroll
            for (int j = 0; j < 8; ++j) u[j] = h[j] * rstd * av[j] + bv[j];
            v4u hi; hi.x = cvt_pk_bf16(u[0], u[1]); hi.y = cvt_pk_bf16(u[2], u[3]); hi.z = cvt_pk_bf16(u[4], u[5]); hi.w = cvt_pk_bf16(u[6], u[7]);
            v4u lo; lo.x = cvt_pk_bf16(u[0] - bflo(hi.x), u[1] - bfhi(hi.x)); lo.y = cvt_pk_bf16(u[2] - bflo(hi.y), u[3] - bfhi(hi.y));
                    lo.z = cvt_pk_bf16(u[4] - bflo(hi.z), u[5] - bfhi(hi.z)); lo.w = cvt_pk_bf16(u[6] - bflo(hi.w), u[7] - bfhi(hi.w));
            { v2u q; q.x = pk4_fp8(u[0], u[1], u[2], u[3]); q.y = pk4_fp8(u[4], u[5], u[6], u[7]); *(GAS v2u*)((unsigned char*)XN + (size_t)(row0 + tkn) * 1024 + 32 * s + 8 * kg) = q; }
            const bf16x8 uhi = __builtin_bit_cast(bf16x8, hi), ulo = __builtin_bit_cast(bf16x8, lo);
            const bf16x8 rh0 = *(const LAS bf16x8*)(size_t)(fa0 + 64 * s), rh1 = *(const LAS bf16x8*)(size_t)(fa1 + 64 * s), rl0 = *(const LAS bf16x8*)(size_t)(fl0 + 64 * s), rl1 = *(const LAS bf16x8*)(size_t)(fl1 + 64 * s);
            acc0 = __builtin_amdgcn_mfma_f32_16x16x32_bf16(rh0, uhi, acc0, 0, 0, 0); acc0 = __builtin_amdgcn_mfma_f32_16x16x32_bf16(rh0, ulo, acc0, 0, 0, 0); acc0 = __builtin_amdgcn_mfma_f32_16x16x32_bf16(rl0, uhi, acc0, 0, 0, 0);
            acc1 = __builtin_amdgcn_mfma_f32_16x16x32_bf16(rh1, uhi, acc1, 0, 0, 0); acc1 = __builtin_amdgcn_mfma_f32_16x16x32_bf16(rh1, ulo, acc1, 0, 0, 0); acc1 = __builtin_amdgcn_mfma_f32_16x16x32_bf16(rl1, uhi, acc1, 0, 0, 0);
        }
        float kx[8];
#pragma unroll
        for (int r = 0; r < 4; ++r) { const int e0 = 4 * kg + r, e1 = 16 + 4 * kg + r; kx[r] = rt_key(acc0[r] + RB[e0], e0); kx[4 + r] = rt_key(acc1[r] + RB[e1], e1); }
        float tv[4]; int te[4];
#pragma unroll
        for (int k = 0; k < 4; ++k) {
            float m = fmaxf(fmaxf(fmaxf(kx[0], kx[1]), fmaxf(kx[2], kx[3])), fmaxf(fmaxf(kx[4], kx[5]), fmaxf(kx[6], kx[7])));
            m = fmaxf(m, __shfl_xor(m, 16)); m = fmaxf(m, __shfl_xor(m, 32));
            const unsigned mb = __builtin_bit_cast(unsigned, m); const int lowb = (int)(mb & 31u);
            te[k] = (mb >> 31) ? lowb : 31 - lowb; tv[k] = __builtin_bit_cast(float, mb & 0xFFFFFFE0u);
#pragma unroll
            for (int i = 0; i < 8; ++i) kx[i] = (kx[i] == m) ? -3.0e38f : kx[i]; }
        const float x1 = __expf(tv[1] - tv[0]), x2 = __expf(tv[2] - tv[0]), x3 = __expf(tv[3] - tv[0]), inv = 1.f / (1.f + x1 + x2 + x3);
        if (kg == 0) { const float gts[4] = {inv, x1 * inv, x2 * inv, x3 * inv};
#pragma unroll
            for (int k = 0; k < 4; ++k) { const int rk = atomicAdd((int*)(hist + te[k]), 1); const int ri = ((F.wave * 2 + slot) * 16 + tkn) * 4 + k; rec_e[ri] = te[k]; rec_r[ri] = rk; rec_g[ri] = gts[k]; } }
    }
    __syncthreads();
    if (F.tid < 32) base[F.tid] = (int)__hip_atomic_fetch_add(F.ctl + CW_CNT + cnt_slot * 32 + F.tid, (unsigned)hist[F.tid], RLX_AGENT);
    __syncthreads();
    float* TOKG = (float*)(ws + WS_TOKG); int* INV = (int*)(ws + WS_INV);
    for (int i = F.tid; i < 1024; i += 512) { const int w = i >> 7, slot = (i >> 6) & 1, tk = (i >> 2) & 15, k = i & 3; const int task = slot == 0 ? (int)blockIdx.x * 8 + w : ((w == 0 && (blockIdx.x & 3) == 0) ? 2048 + (int)(blockIdx.x >> 2) : 0x7fffffff);
        if (task < ntask) { const int row = task * 16 + tk, e = rec_e[i], sl = base[e] + rec_r[i];
            TOKG[(size_t)row * 4 + k] = rec_g[i]; INV[(size_t)e * NTOK + sl] = row * 4 + k; } }
    __syncthreads();
}

DI void dispatch_phase(Frame& F, int layer) {
    unsigned char* const ws = WSP(F);
    moe_tables(F, layer, 8);
    const LAS int* tab = (const LAS int*)(F.lds + TAB_OFF);
    const int gw = blockIdx.x * 8 + F.wave, NGW = F.G * 8, nrows_all = (layer == 3) ? NLAT : NTOK;
    const int* TOKE = (const int*)(ws + WS_TOKE); const int* TOKS = (const int*)(ws + WS_TOKS);
    const bf16* XN = (const bf16*)(ws + WS_XN); bf16* XR = (bf16*)(ws + WS_XR);
#pragma unroll 2
    for (int row = gw; row < nrows_all; row += NGW) {
        int d = 0; if (F.lane < 4) d = tab[TOKE[(size_t)row * 4 + F.lane]] + TOKS[(size_t)row * 4 + F.lane];
        const v4u x0 = ((const GAS v4u*)(XN + (size_t)row * 1024))[F.lane], x1 = ((const GAS v4u*)(XN + (size_t)row * 1024))[64 + F.lane];
#pragma unroll
        for (int k = 0; k < 4; ++k) { const int dr = __shfl(d, k); GAS v4u* o = (GAS v4u*)(XR + (size_t)dr * 1024); o[F.lane] = x0; o[64 + F.lane] = x1; }
    }
}

DI void combine_phase(Frame& F, CArgsP a, int layer, size_t hdst_off) {
    unsigned char* const ws = WSP(F);
    const int gw = blockIdx.x * 8 + F.wave, NGW = F.G * 8, nrows_all = (layer == 3) ? NLAT : NTOK;
    const float* TOKG = (const float*)(ws + WS_TOKG);
    const bf16* YR = (const bf16*)(ws + WS_YR); const bf16* H = (const bf16*)(ws + WS_H); bf16* HD = (bf16*)(ws + hdst_off); bf16* XN = (bf16*)(ws + WS_XN);
    const float* MOD = (const float*)(ws + WS_MOD);
    const int l = F.lane;
    float g2r[16], Ar[16], Sr[16]; int mr_cur = -1;
#pragma unroll 2
    for (int row = gw; row < nrows_all; row += NGW) {
        const int mr = mod_row(row);
        if (mr != mr_cur) { mr_cur = mr; const float* g2 = MOD + (size_t)(layer * 5 + mr) * 6144 + 5 * 1024;
#pragma unroll
            for (int hb = 0; hb < 2; ++hb) { const int k0 = hb * 512 + 8 * l;
#pragma unroll
                for (int q = 0; q < 2; ++q) { const f32x4 g = *(const GAS f32x4*)(g2 + k0 + 4 * q);
#pragma unroll
                    for (int i = 0; i < 4; ++i) g2r[hb * 8 + q * 4 + i] = g[i];
                    if (layer == 3) { const f32x4 g4 = *(const GAS f32x4*)(a->in[I_FING] + k0 + 4 * q);
#pragma unroll
                        for (int i = 0; i < 4; ++i) { Ar[hb * 8 + q * 4 + i] = g4[i]; Sr[hb * 8 + q * 4 + i] = 0.f; }
                    } else { const float* n1g = a->in[I_N1G] + (layer + 1) * 1024; const float* mp = MOD + (size_t)((layer + 1) * 5 + mr) * 6144;
                        const f32x4 g4 = *(const GAS f32x4*)(n1g + k0 + 4 * q), sh = *(const GAS f32x4*)(mp + k0 + 4 * q), sc = *(const GAS f32x4*)(mp + 1024 + k0 + 4 * q);
#pragma unroll
                        for (int i = 0; i < 4; ++i) { Ar[hb * 8 + q * 4 + i] = g4[i] * (1.f + sc[i]); Sr[hb * 8 + q * 4 + i] = sh[i]; } } } } }
        float gt = 0.f; if (l < 4) gt = TOKG[(size_t)row * 4 + l];
        float f[16];
#pragma unroll
        for (int i = 0; i < 16; ++i) f[i] = 0.f;
#pragma unroll
        for (int k = 0; k < 4; ++k) { const float gk = __shfl(gt, k); const GAS v2u* s = (const GAS v2u*)((const unsigned char*)YR + ((size_t)row * 4 + k) * 1024);
            const v2u y0 = s[l], y1 = s[64 + l]; const unsigned w[4] = {y0.x, y0.y, y1.x, y1.y};
#pragma unroll
            for (int q = 0; q < 4; ++q) { const f32x2 lo = __builtin_amdgcn_cvt_pk_f32_fp8((int)w[q], false), hi = __builtin_amdgcn_cvt_pk_f32_fp8((int)w[q], true);
                f[4 * q] += gk * lo.x; f[4 * q + 1] += gk * lo.y; f[4 * q + 2] += gk * hi.x; f[4 * q + 3] += gk * hi.y; } }
        float hv[16]; float ss = 0.f;
#pragma unroll
        for (int hb = 0; hb < 2; ++hb) { const int k0 = hb * 512 + 8 * l; const v4u hw = *(const GAS v4u*)(H + (size_t)row * 1024 + k0); const unsigned hs[4] = {hw.x, hw.y, hw.z, hw.w};
#pragma unroll
            for (int i = 0; i < 8; ++i) { const float h = (i & 1) ? bfhi(hs[i >> 1]) : bflo(hs[i >> 1]); const float o = h + g2r[hb * 8 + i] * f[hb * 8 + i]; hv[hb * 8 + i] = o; ss += o * o; }
            v4u ow; ow.x = pk2(hv[hb * 8], hv[hb * 8 + 1]); ow.y = pk2(hv[hb * 8 + 2], hv[hb * 8 + 3]); ow.z = pk2(hv[hb * 8 + 4], hv[hb * 8 + 5]); ow.w = pk2(hv[hb * 8 + 6], hv[hb * 8 + 7]);
            *(GAS v4u*)(HD + (size_t)row * 1024 + k0) = ow; }
        const float rstd = 1.f / sqrtf(wave_sum(ss) * (1.f / 1024.f) + EPS);
        if (layer == 3) {
#pragma unroll
            for (int hb = 0; hb < 2; ++hb)
#pragma unroll
                for (int q = 0; q < 2; ++q) { const int k0 = hb * 512 + 8 * l + 4 * q; f32x4 o;
#pragma unroll
                    for (int i = 0; i < 4; ++i) o[i] = hv[hb * 8 + q * 4 + i] * rstd * Ar[hb * 8 + q * 4 + i];
                    *(GAS f32x4*)(a->out + (size_t)row * 1024 + k0) = o; }
        } else {
#pragma unroll
            for (int hb = 0; hb < 2; ++hb) { const int k0 = hb * 512 + 8 * l; float y[8];
#pragma unroll
                for (int i = 0; i < 8; ++i) y[i] = hv[hb * 8 + i] * rstd * Ar[hb * 8 + i] + Sr[hb * 8 + i];
                v4u o; o.x = pk2(y[0], y[1]); o.y = pk2(y[2], y[3]); o.z = pk2(y[4], y[5]); o.w = pk2(y[6], y[7]);
                *(GAS v4u*)(XN + (size_t)row * 1024 + k0) = o; }
        }
    }
}
constexpr int N_PHASES = 2 + 11 * 4;
#ifndef MK_REP
#define MK_REP 0
#endif
#ifndef MK_MULTI
#define MK_MULTI 0
#endif

__global__ void __launch_bounds__(512, 2) mega_fwd(Args args) {
    extern __shared__ __attribute__((aligned(16))) unsigned char lds_raw[];
    Frame F;
    F.lds = (LAS unsigned char*)lds_raw; F.MISC = (volatile LAS unsigned*)(F.lds + MISC_OFF);
    F.wave = __builtin_amdgcn_readfirstlane((int)threadIdx.x >> 6); F.lane = lane_id(); F.tid = F.wave * 64 + F.lane;
    F.G = gridDim.x; F.vcu = blockIdx.x; F.ws = kargs()->ws; F.ctl = (gu32*)(F.ws + WS_CTL);
    if (F.tid < 64) F.MISC[F.tid] = 0u;
    __syncthreads();
    const int lo = kargs()->ph_lo, hi = kargs()->ph_hi;
    XcdBarrier bar; bar.bar = (unsigned*)(F.ctl + CW_BAR); bar.x = 0; bar.st = nullptr; bar.wv = F.wave;
    if (hi - lo > 1) bar = xcd_barrier_post((unsigned*)(F.ctl + CW_BAR), F.MISC + 8, F.wave);
#ifndef MK_ONLY
#define MK_ONLY 0xFFFFFFFFu
#endif
#define IN(k) (lo <= (k) && (k) < hi)
#define ON(bit) ((MK_ONLY >> (bit)) & 1u)
#define SEAM(k) do { if ((k) + 1 < hi) xcd_barrier(bar); } while (0)
    const int G = F.G, bid = (G % 8 == 0) ? (int)((blockIdx.x & 7) * (G >> 3) + (blockIdx.x >> 3)) : (int)blockIdx.x, rbid = G - 1 - bid, repm = kargs()->rep;
            constexpr size_t T1024 = 256 * 1024 * 2, T768 = 256 * 768 * 2, T512 = 256 * 512 * 2;

    if (ON(0) && IN(0)) for (int rr_ = 0, nr_ = 1 + ((repm >> 0) & 1); rr_ < nr_; ++rr_) { { Frame Fp = refresh(F); prologue0(Fp, kargs()); } SEAM(0); }
    if (ON(1) && IN(1)) for (int rr_ = 0, nr_ = 1 + ((repm >> 1) & 1); rr_ < nr_; ++rr_) { { Frame Fp = refresh(F); prologue1(Fp, kargs()); } SEAM(1); }

#pragma unroll 1
    for (int L = 0; L < 4; ++L) {
        const int pb = 2 + 11 * L, j = L >> 1;
#define ws WSP(F)
#define MOD ((const float*)(WSP(F) + WS_MOD))
        if ((L & 1) == 0) {
            if (ON(2) && IN(pb + 0)) for (int rr_ = 0, nr_ = 1 + ((repm >> 2) & 1); rr_ < nr_; ++rr_) {
                { pg8::Gemm g{1024, 1024, 1024, F.wave}; PlainOrder S{(const char*)(ws + WS_XN), (const char*)(ws + WS_WEV_S5) + (size_t)j * 768 * 1024 * 2, T1024, T1024, 132, 3, G, bid, 3};
                  EpiUG E{(bf16*)(ws + WS_UG)}; pg8::gemm_phase(F.lds, g, S, E); }
                { pg8::Gemm g{1024, 1024, 1024, F.wave}; PlainOrder S{(const char*)(ws + WS_WEV_PQ) + (size_t)j * 512 * 1024 * 2, (const char*)(ws + WS_XN), T1024, T1024, 2, 132, G, rbid, 16};
                  EpiPQt E{(bf16*)(ws + WS_PQT)}; pg8::gemm_phase(F.lds, g, S, E); }
                SEAM(pb + 0);
            }
            if (ON(3) && IN(pb + 1)) for (int rr_ = 0, nr_ = 1 + ((repm >> 3) & 1); rr_ < nr_; ++rr_) {
                { pg8::Gemm g{512, 768, 512, F.wave}; GroupOrder S{(const char*)(ws + WS_UG), (const char*)(ws + WS_EOUT) + (size_t)j * 48 * 256 * 512 * 2, T768, T512, (size_t)S5ROWS * S5K * 2, (size_t)256 * 512 * 2, 5, 1, 48, G, bid};
                  EpiSloc E{(float*)(ws + WS_SLOC)}; pg8::gemm_phase(F.lds, g, S, E); }
                { Frame Fp = refresh(F); fft_phase(Fp, true); }
                SEAM(pb + 1);
            }
            if (ON(4) && IN(pb + 2)) for (int rr_ = 0, nr_ = 1 + ((repm >> 4) & 1); rr_ < nr_; ++rr_) { { Frame Fp = refresh(F); s5_carry_phase(Fp, j); } SEAM(pb + 2); }
            if (ON(5) && IN(pb + 3)) for (int rr_ = 0, nr_ = 1 + ((repm >> 5) & 1); rr_ < nr_; ++rr_) {
                pg8::Gemm g{768, 768, 768, F.wave}; GroupOrder S{(const char*)(ws + WS_UG), (const char*)(ws + WS_WC) + (size_t)j * 48 * 512 * 768 * 2, T768, T768, (size_t)S5ROWS * S5K * 2, (size_t)512 * 768 * 2, 5, 2, 48, G, bid};
                EpiS5Out E{(bf16*)(ws + WS_YB)}; pg8::gemm_phase(F.lds, g, S, E);
                SEAM(pb + 3);
            }
            if (ON(6) && IN(pb + 4)) for (int rr_ = 0, nr_ = 1 + ((repm >> 6) & 1); rr_ < nr_; ++rr_) {
                pg8::Gemm g{768, 768, 768, F.wave}; PlainOrder S{(const char*)(ws + WS_YB), (const char*)(ws + WS_GLUW) + (size_t)j * 768 * 768 * 2, T768, T768, 132, 3, G, bid, 3};
                EpiGLU E{(const bf16*)(ws + WS_YB), (const bf16*)(ws + WS_B1H + 768 * 1024) + j * 768, (bf16*)(ws + WS_CAT)}; pg8::gemm_phase(F.lds, g, S, E);
                SEAM(pb + 4);
            }
            if (ON(7) && IN(pb + 5)) for (int rr_ = 0, nr_ = 1 + ((repm >> 7) & 1); rr_ < nr_; ++rr_) {
                pg8::Gemm g{512, 512, 64, F.wave, 32768}; PlainOrder S{(const char*)(ws + WS_CAT), (const char*)(ws + WS_WEV_OUT) + (size_t)j * 1048576, T512, T512, 132, 4, G, bid, 4, (const char*)(ws + WS_SC3) + (size_t)j * 32768, true};
                EpiResid E{(bf16*)(ws + WS_H), MOD + (size_t)L * 5 * 6144 + 2048}; pg8::gemm_phase<EpiResid, PlainOrder, false, true>(F.lds, g, S, E);
                SEAM(pb + 5);
            }
        } else {
            if (ON(8) && IN(pb + 0)) for (int rr_ = 0, nr_ = 1 + ((repm >> 8) & 1); rr_ < nr_; ++rr_) {
                { pg8::Gemm g{1024, 1024, 1024, F.wave}; PlainOrder S{(const char*)(ws + WS_XN), (const char*)(ws + WS_WOD_IN) + (size_t)j * 2560 * 1024 * 2, T1024, T1024, 132, 8, G, bid, 4, nullptr, true};
                  EpiOddIn E{(bf16*)(ws + WS_U), (bf16*)(ws + WS_VS), (bf16*)(ws + WS_Q), (bf16*)(ws + WS_KALL), (const float*)(ws + WS_ROPE), 0.125f * 1.4426950408889634f}; pg8::gemm_phase(F.lds, g, S, E); }
                { pg8::Gemm g{1024, 1024, 1024, F.wave}; PlainOrder S{(const char*)(ws + WS_WOD_IN) + ((size_t)j * 2560 + 2048) * 1024 * 2, (const char*)(ws + WS_XN), T1024, T1024, 2, 132, G, rbid, 16, nullptr, true};
                  EpiVT E{(bf16*)(ws + WS_VT)}; pg8::gemm_phase(F.lds, g, S, E); }
                SEAM(pb + 0);
            }
            if (ON(9) && IN(pb + 1)) for (int rr_ = 0, nr_ = 1 + ((repm >> 9) & 1); rr_ < nr_; ++rr_) {
                const int natt = (L == 1) ? 528 : 512;
                Frame Fp = refresh(F);
                for (int u = bid; u < natt; u += G) {
                    if (u < 512) attn_unit(Fp, kargs(), j, L, (u >> 7) * SEQ + (u & 31) * 256, u >> 7, (u >> 5) & 3, KV_LEN);
                    else { const int v = u - 512; attn_unit(Fp, kargs(), j, L, NLAT + (v >> 2) * CTXL, v >> 2, v & 3, CTXL); }
                }
                const int nsgu = ((L == 1) ? 264 : 256) * 4;
                if (L == 1 && G == 256) {
                    if (bid < 16) sgu_unit(Fp, kargs(), j, bid >> 2, bid & 3);
                    else for (int u = bid; u < nsgu; u += 240) sgu_unit(Fp, kargs(), j, u >> 2, u & 3);
                } else
                for (int u = rbid; u < nsgu; u += G) sgu_unit(Fp, kargs(), j, u >> 2, u & 3);
                SEAM(pb + 1);
            }
            if (ON(10) && IN(pb + 2)) for (int rr_ = 0, nr_ = 1 + ((repm >> 10) & 1); rr_ < nr_; ++rr_) {
                pg8::Gemm g{512, 512, 64, F.wave, 32768}; PlainOrder S{(const char*)(ws + WS_CAT), (const char*)(ws + WS_WOD_OUT) + (size_t)j * 1048576, T512, T512, (L == 3) ? 128 : 132, 4, G, bid, 4, (const char*)(ws + WS_SC3) + 65536 + (size_t)j * 32768, true};
                EpiResid E{(bf16*)(ws + WS_H), MOD + (size_t)L * 5 * 6144 + 2048}; pg8::gemm_phase<EpiResid, PlainOrder, false, true>(F.lds, g, S, E);
                SEAM(pb + 2);
            }
        }
        if (ON(11) && IN(pb + 6)) for (int rr_ = 0, nr_ = 1 + ((repm >> 11) & 1); rr_ < nr_; ++rr_) { { Frame Fp = refresh(F); router_phase(Fp, kargs(), L, (rr_ + 1 < nr_) ? L + 4 : L); } SEAM(pb + 6); }
        if (ON(13) && IN(pb + 8)) for (int rr_ = 0, nr_ = 1 + ((repm >> 13) & 1); rr_ < nr_; ++rr_) {
            { Frame Fp = refresh(F); moe_tables(Fp, L, 8); }
            pg8::Gemm g{512, 512, 64, F.wave, 32768}; MoeOrder S{(const char*)(ws + WS_XN), (const char*)(ws + WS_W1T) + (size_t)L * 32 * 2048 * 1024, (size_t)2048 * 1024, T512, 8, G, bid, (const LAS int*)(F.lds + TAB_OFF), (const int*)(ws + WS_INV), true, (const char*)(ws + WS_SC1) + (size_t)L * 32 * 65536, 65536};
            EpiSwiglu E{(const bf16*)(ws + WS_B1H) + (size_t)L * 32 * 2048, (bf16*)(ws + WS_ACT)};
            pg8::gemm_phase<EpiSwiglu, MoeOrder, true, true>(F.lds, g, S, E);
            SEAM(pb + 8);
        }
        if (ON(14) && IN(pb + 9)) for (int rr_ = 0, nr_ = 1 + ((repm >> 14) & 1); rr_ < nr_; ++rr_) {
            { Frame Fp = refresh(F); moe_tables(Fp, L, 4); }
            pg8::Gemm g{512, 512, 64, F.wave, 32768}; MoeOrder S{(const char*)(ws + WS_ACT), (const char*)(ws + WS_W2T) + (size_t)L * 32 * 1024 * 1024, (size_t)1024 * 1024, T512, 4, G, bid, (const LAS int*)(F.lds + TAB_OFF), (const int*)(ws + WS_INV), false, (const char*)(ws + WS_SC2) + (size_t)L * 32 * 32768, 32768};
            EpiMoe2 E{(const bf16*)(ws + WS_B1H + 512 * 1024) + (size_t)L * 32 * 1024, (bf16*)(ws + WS_YR)}; pg8::gemm_phase<EpiMoe2, MoeOrder, false, true>(F.lds, g, S, E);
            SEAM(pb + 9);
        }
        if (ON(15) && IN(pb + 10)) for (int rr_ = 0, nr_ = 1 + ((repm >> 15) & 1); rr_ < nr_; ++rr_) { { Frame Fp = refresh(F); combine_phase(Fp, kargs(), L, (rr_ + 1 < nr_) ? WS_PQT : WS_H); } SEAM(pb + 10); }
    }
#undef ws
#undef MOD
#undef IN
#undef SEAM
}

extern "C" void kernel_launch(void* const* d_in, const int* in_sizes, int n_in, void* d_out, int out_size, void* d_ws, size_t ws_size, hipStream_t stream) {
    static int grid = 0;
    if (grid == 0) {
        if (n_in != 38 || out_size != NLAT * DM || ws_size < WS_END) { fprintf(stderr, "kernel_launch: unexpected shapes (n_in %d, out %d, ws %zu)\n", n_in, out_size, ws_size); grid = -1; return; }
        int dev = 0, cus = 0;
        if (hipGetDevice(&dev) != hipSuccess || hipDeviceGetAttribute(&cus, hipDeviceAttributeMultiprocessorCount, dev) != hipSuccess) { grid = -1; return; }
        if (hipFuncSetAttribute((const void*)mega_fwd, hipFuncAttributeMaxDynamicSharedMemorySize, LDS_BYTES) != hipSuccess) { fprintf(stderr, "kernel_launch: hipFuncSetAttribute failed\n"); grid = -1; return; }
        (void)hipGetLastError();
        grid = cus;
        if (grid != 256) { fprintf(stderr, "kernel_launch: %d CUs; this kernel is built for 256\n", grid); grid = -1; return; }
    }
    if (grid < 0) return;
    if (hipMemsetAsync((char*)d_ws + WS_CTL, 0, CTL_ZERO_BYTES, stream) != hipSuccess) return;
    Args a{};
    for (int i = 0; i < 38; ++i) a.in[i] = (const float*)d_in[i];
    a.out = (float*)d_out; a.ws = (unsigned char*)d_ws; a.rep = MK_REP; a.pad = 0;
#if MK_MULTI
    for (int p = 0; p < N_PHASES; ++p) {
        if (p >= 2) { const int L = (p - 2) / 11, q = (p - 2) % 11; if (((L & 1) && q >= 3 && q <= 5) || q == 7) continue; }
        a.ph_lo = p; a.ph_hi = p + 1;
        hipLaunchKernelGGL(mega_fwd, dim3(grid), dim3(512), LDS_BYTES, stream, a);
    }
#else
    a.ph_lo = 0; a.ph_hi = N_PHASES;
    hipLaunchKernelGGL(mega_fwd, dim3(grid), dim3(512), LDS_BYTES, stream, a);
#endif
}
```
